# Optimizing an MI355X kernel written in HIP

```python
import jax, jax.numpy as jnp
from jax import lax
import numpy as np

D_MODEL = 1024
BATCH = 8
SEQ = 2048
DEPTH = 2

HEAD_DIM = 64
N_HEADS = D_MODEL // HEAD_DIM
N_MEM_HEADS = 4
MEM_LEN = 256
DILATED_PATTERNS = ((128, 1), (512, 4), (2048, 16))
N_DIL_GROUPS = len(DILATED_PATTERNS)
DIL_HEADS_PER_GROUP = (N_HEADS - N_MEM_HEADS) // N_DIL_GROUPS
N_FOX_HEADS = N_HEADS - N_MEM_HEADS
Q_BLOCK = 128
N_A_LAYERS = DEPTH // 2
N_B_LAYERS = DEPTH - N_A_LAYERS
DIL_QKV_WIDTH = N_DIL_GROUPS * 3 * DIL_HEADS_PER_GROUP * HEAD_DIM
MEM_WIDTH = N_MEM_HEADS * HEAD_DIM
FOX_WIDTH = N_FOX_HEADS * HEAD_DIM
A_IN = DIL_QKV_WIDTH + MEM_WIDTH
A_OUT = DIL_HEADS_PER_GROUP * HEAD_DIM + MEM_WIDTH
B_IN = FOX_WIDTH + MEM_WIDTH
B_OUT = FOX_WIDTH + MEM_WIDTH
N_EXPERTS = 32
TOP_K = 4
D_FF = D_MODEL
SWIGLU_LIMIT = 7.0
SWIGLU_ALPHA = 1.702
MOE_BLOCK = 128
ROPE_THETA = 10000.0
LN_EPS = 1e-5
ATTN_SCALE = HEAD_DIM ** -0.5
DEEPNORM_ALPHA = (2.0 * DEPTH) ** 0.25
DEEPNORM_BETA = (8.0 * DEPTH) ** -0.25

kernel_name = 'yoco_dilated_fox_memory_moe_deepnorm'


def _layer_norm(x, g, b):
    xf = x.astype(jnp.float32)
    mu = jnp.mean(xf, axis=-1, keepdims=True)
    var = jnp.mean(jnp.square(xf - mu), axis=-1, keepdims=True)
    return ((xf - mu) * lax.rsqrt(var + LN_EPS)).astype(x.dtype) * g + b


def _rope_tables(seq, dtype):
    inv = 1.0 / (ROPE_THETA ** (jnp.arange(0, HEAD_DIM, 2, dtype=jnp.float32) / HEAD_DIM))
    ang = jnp.arange(seq, dtype=jnp.float32)[:, None] * inv[None, :]
    return jnp.cos(ang)[:, None, :].astype(dtype), jnp.sin(ang)[:, None, :].astype(dtype)


def _rope(t, cos, sin):
    t1, t2 = jnp.split(t, 2, axis=-1)
    return jnp.concatenate([t1 * cos - t2 * sin, t2 * cos + t1 * sin], axis=-1)


def _dilated_group_attention(q, k, v, dilation, steps):
    b, s, h, c = q.shape
    length = s // dilation
    nb = -(-length // steps)
    lp = nb * steps

    def to_blocks(t):
        t = t.reshape(b, length, dilation, h, c).transpose(0, 2, 3, 1, 4)
        t = jnp.pad(t, ((0, 0), (0, 0), (0, 0), (0, lp - length), (0, 0)))
        return t.reshape(b, dilation, h, nb, steps, c)

    def with_prev(t):
        prev = jnp.pad(t[:, :, :, :-1], ((0, 0), (0, 0), (0, 0), (1, 0), (0, 0), (0, 0)))
        return jnp.concatenate([prev, t], axis=4)

    qb, kb, vb = to_blocks(q), to_blocks(k), to_blocks(v)
    kk, vv = with_prev(kb), with_prev(vb)
    scores = jnp.einsum('brhnqc,brhnkc->brhnqk', qb, kk).astype(jnp.float32)
    qi = jnp.arange(steps)[:, None]
    kj = jnp.arange(2 * steps)[None, :]
    band = (kj >= qi) & (kj <= qi + steps)
    valid_start = (jnp.arange(nb)[:, None, None] > 0) | (kj >= steps)[None]
    mask = band[None] & valid_start
    scores = jnp.where(mask, scores, -jnp.inf)
    m = jnp.max(scores, axis=-1, keepdims=True)
    p = jnp.exp(scores - m)
    den = jnp.sum(p, axis=-1)
    o = jnp.einsum('brhnqk,brhnkc->brhnqc', p.astype(v.dtype), vv) / den[..., None].astype(v.dtype)
    lse = m[..., 0] + jnp.log(den)
    o = o.reshape(b, dilation, h, lp, c)[:, :, :, :length].transpose(0, 3, 1, 2, 4).reshape(b, s, h, c)
    lse = lse.reshape(b, dilation, h, lp)[..., :length].transpose(0, 3, 1, 2).reshape(b, s, h)
    return o, lse


def _forgetting_attention(q, k, v, log_f_cum):
    b, s, h, c = q.shape
    nb = s // Q_BLOCK
    c_all = log_f_cum.transpose(0, 2, 1)
    q_blocks = q.reshape(b, nb, Q_BLOCK, h, c).transpose(1, 0, 2, 3, 4)
    kpos = jnp.arange(s)

    def one_block(args):
        qb, blk = args
        start = blk * Q_BLOCK
        c_q = lax.dynamic_slice_in_dim(c_all, start, Q_BLOCK, axis=2)
        scores = (jnp.einsum('bqhc,bkhc->bhqk', qb, k).astype(jnp.float32)
                  + c_q[..., None] - c_all[:, :, None, :])
        causal = kpos[None, :] <= (start + jnp.arange(Q_BLOCK))[:, None]
        p = jax.nn.softmax(jnp.where(causal, scores, -jnp.inf), axis=-1)
        return jnp.einsum('bhqk,bkhc->bqhc', p.astype(v.dtype), v)

    out = lax.map(one_block, (q_blocks, jnp.arange(nb)))
    return out.transpose(1, 0, 2, 3, 4).reshape(b, s, h, c)


def _memory_attention(q, mem_k, mem_v):
    scores = jnp.einsum('bqhc,bmhc->bhqm', q, mem_k).astype(jnp.float32)
    p = jax.nn.softmax(scores, axis=-1)
    return jnp.einsum('bhqm,bmhc->bqhc', p.astype(mem_v.dtype), mem_v)


def _mixer_a(x, w_in, w_out, mem_k, mem_v, cos, sin):
    b, s, _ = x.shape
    h = x @ w_in
    qkv = h[..., :DIL_QKV_WIDTH].reshape(b, s, N_DIL_GROUPS, 3, DIL_HEADS_PER_GROUP, HEAD_DIM)
    q_mem = h[..., DIL_QKV_WIDTH:].reshape(b, s, N_MEM_HEADS, HEAD_DIM) * ATTN_SCALE
    outs, lses = [], []
    for g, (window, dilation) in enumerate(DILATED_PATTERNS):
        q = _rope(qkv[:, :, g, 0], cos, sin) * ATTN_SCALE
        k = _rope(qkv[:, :, g, 1], cos, sin)
        o, lse = _dilated_group_attention(q, k, qkv[:, :, g, 2], dilation, window // dilation)
        outs.append(o)
        lses.append(lse)
    wts = jax.nn.softmax(jnp.stack(lses), axis=0).astype(x.dtype)
    dil = jnp.einsum('gbsh,gbshc->bshc', wts, jnp.stack(outs))
    memo = _memory_attention(q_mem, mem_k, mem_v)
    merged = jnp.concatenate([dil.reshape(b, s, -1), memo.reshape(b, s, -1)], axis=-1)
    return merged @ w_out


def _mixer_b(x, w_in, w_out, mem_k, mem_v, k_sh, v_sh, log_f_cum):
    b, s, _ = x.shape
    h = x @ w_in
    q_fox = h[..., :FOX_WIDTH].reshape(b, s, N_FOX_HEADS, HEAD_DIM) * ATTN_SCALE
    q_mem = h[..., FOX_WIDTH:].reshape(b, s, N_MEM_HEADS, HEAD_DIM) * ATTN_SCALE
    fox = _forgetting_attention(q_fox, k_sh, v_sh, log_f_cum)
    memo = _memory_attention(q_mem, mem_k, mem_v)
    merged = jnp.concatenate([fox.reshape(b, s, -1), memo.reshape(b, s, -1)], axis=-1)
    return merged @ w_out


def _shared_kv(x, w_shared, b_forget):
    b, s, _ = x.shape
    h = x @ w_shared
    kv = h[..., :2 * FOX_WIDTH].reshape(b, s, 2, N_FOX_HEADS, HEAD_DIM)
    f_logit = (h[..., 2 * FOX_WIDTH:] + b_forget).astype(jnp.float32)
    log_f_cum = jnp.cumsum(jax.nn.log_sigmoid(f_logit), axis=1)
    return kv[:, :, 0], kv[:, :, 1], log_f_cum


def _moe(x2, w_r, b_r, w_gu, b_gu, w_dn, b_dn):
    n, d = x2.shape
    logits = (x2 @ w_r + b_r).astype(jnp.float32)
    top_v, top_i = lax.top_k(logits, TOP_K)
    gates = jax.nn.softmax(top_v, axis=-1).astype(x2.dtype)
    a = n * TOP_K
    e_flat = top_i.reshape(a)
    tok_flat = jnp.repeat(jnp.arange(n, dtype=jnp.int32), TOP_K)
    g_flat = gates.reshape(a)
    order = jnp.argsort(e_flat)
    e_s, tok_s, g_s = e_flat[order], tok_flat[order], g_flat[order]
    counts = jnp.zeros((N_EXPERTS,), jnp.int32).at[e_flat].add(1)
    padded = (counts + MOE_BLOCK - 1) // MOE_BLOCK * MOE_BLOCK
    pend = jnp.cumsum(padded)
    pstart = pend - padded
    ustart = jnp.cumsum(counts) - counts
    dest = pstart[e_s] + (jnp.arange(a, dtype=jnp.int32) - ustart[e_s])
    n_blocks = -(-a // MOE_BLOCK) + N_EXPERTS
    rows = n_blocks * MOE_BLOCK
    row_tok = jnp.full((rows,), n, jnp.int32).at[dest].set(tok_s)
    row_gate = jnp.zeros((rows,), x2.dtype).at[dest].set(g_s)
    block_exp = jnp.minimum(
        jnp.searchsorted(pend, jnp.arange(n_blocks, dtype=jnp.int32) * MOE_BLOCK, side='right'),
        N_EXPERTS - 1)
    x_pad = jnp.concatenate([x2, jnp.zeros((1, d), x2.dtype)], axis=0)

    def expert_block(args):
        toks, gts, e = args
        hb = x_pad[toks] @ w_gu[e] + b_gu[e]
        gate = jnp.minimum(hb[:, :D_FF], SWIGLU_LIMIT)
        up = jnp.clip(hb[:, D_FF:], -SWIGLU_LIMIT, SWIGLU_LIMIT)
        act = (up + 1.0) * gate * jax.nn.sigmoid(SWIGLU_ALPHA * gate)
        return (act @ w_dn[e] + b_dn[e]) * gts[:, None]

    y_rows = lax.map(expert_block, (row_tok.reshape(n_blocks, MOE_BLOCK),
                                    row_gate.reshape(n_blocks, MOE_BLOCK), block_exp))
    y = jax.ops.segment_sum(y_rows.reshape(rows, d), row_tok, num_segments=n + 1)
    return y[:n]


def setup_inputs(seed: int = 0) -> dict:
    key = jax.random.key(seed)
    ks = jax.random.split(key, 20)

    def nrm(k, shape, fan_in, gain=1.0):
        return jax.random.normal(k, shape, jnp.float32) * (gain * fan_in ** -0.5)

    x = jax.random.normal(ks[0], (BATCH, SEQ, D_MODEL), jnp.float32)
    mem = jax.random.normal(ks[1], (BATCH, MEM_LEN, D_MODEL), jnp.float32)
    w_in_a = nrm(ks[2], (N_A_LAYERS, D_MODEL, A_IN), D_MODEL)
    w_out_a = nrm(ks[3], (N_A_LAYERS, A_OUT, D_MODEL), A_OUT, DEEPNORM_BETA)
    w_in_b = nrm(ks[4], (N_B_LAYERS, D_MODEL, B_IN), D_MODEL)
    w_out_b = nrm(ks[5], (N_B_LAYERS, B_OUT, D_MODEL), B_OUT, DEEPNORM_BETA)
    w_shared_kvf = jnp.concatenate([nrm(ks[6], (D_MODEL, 2 * FOX_WIDTH), D_MODEL),
                                    nrm(ks[7], (D_MODEL, N_FOX_HEADS), D_MODEL, 0.5)], axis=1)
    b_forget = jax.random.uniform(ks[8], (N_FOX_HEADS,), jnp.float32, minval=1.0, maxval=4.0)
    w_mem_kv = nrm(ks[9], (DEPTH, D_MODEL, 2 * MEM_WIDTH), D_MODEL)
    ln_mix_g = 1.0 + 0.02 * jax.random.normal(ks[10], (DEPTH, D_MODEL), jnp.float32)
    ln_mix_b = 0.02 * jax.random.normal(ks[11], (DEPTH, D_MODEL), jnp.float32)
    ln_ffn_g = 1.0 + 0.02 * jax.random.normal(ks[12], (DEPTH, D_MODEL), jnp.float32)
    ln_ffn_b = 0.02 * jax.random.normal(ks[13], (DEPTH, D_MODEL), jnp.float32)
    w_router = nrm(ks[14], (DEPTH, D_MODEL, N_EXPERTS), D_MODEL)
    b_router = 0.01 * jax.random.normal(ks[15], (DEPTH, N_EXPERTS), jnp.float32)
    w_gate_up = nrm(ks[16], (DEPTH, N_EXPERTS, D_MODEL, 2 * D_FF), D_MODEL)
    b_gate_up = 0.01 * jax.random.normal(ks[17], (DEPTH, N_EXPERTS, 2 * D_FF), jnp.float32)
    w_down = nrm(ks[18], (DEPTH, N_EXPERTS, D_FF, D_MODEL), D_FF, DEEPNORM_BETA)
    b_down = 0.01 * jax.random.normal(ks[19], (DEPTH, N_EXPERTS, D_MODEL), jnp.float32)
    return {'x': x, 'mem': mem, 'w_in_a': w_in_a, 'w_out_a': w_out_a, 'w_in_b': w_in_b,
            'w_out_b': w_out_b, 'w_shared_kvf': w_shared_kvf, 'b_forget': b_forget,
            'w_mem_kv': w_mem_kv, 'ln_mix_g': ln_mix_g, 'ln_mix_b': ln_mix_b,
            'ln_ffn_g': ln_ffn_g, 'ln_ffn_b': ln_ffn_b, 'w_router': w_router,
            'b_router': b_router, 'w_gate_up': w_gate_up, 'b_gate_up': b_gate_up,
            'w_down': w_down, 'b_down': b_down}


def reference(x, mem, w_in_a, w_out_a, w_in_b, w_out_b, w_shared_kvf, b_forget, w_mem_kv,
              ln_mix_g, ln_mix_b, ln_ffn_g, ln_ffn_b, w_router, b_router, w_gate_up, b_gate_up,
              w_down, b_down):
    b, s, d = x.shape
    m_len = mem.shape[1]
    cos, sin = _rope_tables(s, x.dtype)
    shared = None
    for layer in range(DEPTH):
        mkv = jnp.einsum('bmd,de->bme', mem, w_mem_kv[layer]).reshape(b, m_len, 2, N_MEM_HEADS, HEAD_DIM)
        mem_k, mem_v = mkv[:, :, 0], mkv[:, :, 1]
        if layer < N_A_LAYERS:
            mix = _mixer_a(x, w_in_a[layer], w_out_a[layer], mem_k, mem_v, cos, sin)
        else:
            j = layer - N_A_LAYERS
            mix = _mixer_b(x, w_in_b[j], w_out_b[j], mem_k, mem_v, shared[0], shared[1], shared[2])
        x = _layer_norm(DEEPNORM_ALPHA * x + mix, ln_mix_g[layer], ln_mix_b[layer])
        ffn = _moe(x.reshape(b * s, d), w_router[layer], b_router[layer], w_gate_up[layer],
                   b_gate_up[layer], w_down[layer], b_down[layer]).reshape(b, s, d)
        x = _layer_norm(DEEPNORM_ALPHA * x + ffn, ln_ffn_g[layer], ln_ffn_b[layer])
        if layer == N_A_LAYERS - 1:
            shared = _shared_kv(x, w_shared_kvf, b_forget)
    return x
```

```cpp
#include <hip/hip_runtime.h>
#include <cstdio>
#include <cstdint>

typedef unsigned short bf16_t;
typedef float f32x4 __attribute__((ext_vector_type(4)));
typedef float f32x2 __attribute__((ext_vector_type(2)));
typedef unsigned u32x4 __attribute__((ext_vector_type(4)));
typedef unsigned u32x2 __attribute__((ext_vector_type(2)));

constexpr int DM = 1024, NB = 8, SEQ = 2048, NTOK = NB * SEQ, HD = 64;
constexpr int MEM_LEN = 256, NMEMROW = NB * MEM_LEN;
constexpr int A_IN = 2560, A_OUT = 512, B_IN = 2560  , B_OUT = 1024;
constexpr int NEXP = 32, TOPK = 4, DFF = 1024, ECAP = NTOK;
constexpr int NFOX = 12;
constexpr int MAXROWS = 73728;
constexpr size_t LA_K = (size_t)3 * 8 * 4 * 2048 * 64, LA_QM = 3 * LA_K;
constexpr size_t LB_V = (size_t)768 * 16384, LB_QF = 2 * LB_V, LB_QM = 3 * LB_V;
constexpr float LN_EPS = 1e-5f;
constexpr float DN_ALPHA = 1.4142135623730951f;
constexpr float C2 = 0.125f * 1.4426950408889634f;
constexpr float LOG2E = 1.4426950408889634f;
constexpr float SW_LIMIT = 7.0f, SW_ALPHA = 1.702f;

constexpr size_t MiB = 1ull << 20;
constexpr size_t WS_CTL = 0;
constexpr size_t WS_ROPE = 1 * MiB;
constexpr size_t WS_CUM = 2 * MiB;
constexpr size_t WS_FLOG = 3 * MiB;
constexpr size_t WS_ROWTOK = 4 * MiB;
constexpr size_t WS_ROWGATE = 6 * MiB;
constexpr size_t WS_TOKPOS = 8 * MiB;
constexpr size_t WS_MEMB = 10 * MiB;
constexpr size_t WS_MEMKV = 14 * MiB;
constexpr size_t WS_WT_INA = 18 * MiB;
constexpr size_t WS_WT_INB = 23 * MiB;
constexpr size_t WS_WT_OUTA = 28 * MiB;
constexpr size_t WS_WT_OUTB = 29 * MiB;
constexpr size_t WS_WT_MKV = 31 * MiB;
constexpr size_t WS_XB = 34 * MiB;
constexpr size_t WS_X1B = 66 * MiB;
constexpr size_t WS_QKV = 98 * MiB;
constexpr size_t WS_MERGED = 178 * MiB;
constexpr size_t WS_PRE = 210 * MiB;
constexpr size_t WS_X1 = 274 * MiB;
constexpr size_t WS_X2 = 338 * MiB;
constexpr size_t WS_ACT = 402 * MiB;
constexpr size_t WS_YROWS = 546 * MiB;
constexpr size_t WS_WT_GU = 690 * MiB;
constexpr size_t WS_WT_DN = 946 * MiB;
constexpr size_t WS_CKB = 1074 * MiB;
constexpr size_t WS_END = 1078 * MiB;
constexpr int CW_CNT = 64;

__device__ __forceinline__ float bf2f(bf16_t v) { return __uint_as_float((unsigned)v << 16); }
__device__ __forceinline__ unsigned f2bf(float f) { unsigned u = __float_as_uint(f); return (u + 0x7fffu + ((u >> 16) & 1u)) >> 16; }
typedef __bf16 hwbf16x2_t __attribute__((ext_vector_type(2)));
__device__ __forceinline__ unsigned pk2(float lo, float hi) { f32x2 v = {lo, hi}; hwbf16x2_t b = __builtin_convertvector(v, hwbf16x2_t); return __builtin_bit_cast(unsigned, b); }
__device__ __forceinline__ void unpack8(const u32x4 w, float* f) {
    f[0] = __uint_as_float(w.x << 16); f[1] = __uint_as_float(w.x & 0xffff0000u);
    f[2] = __uint_as_float(w.y << 16); f[3] = __uint_as_float(w.y & 0xffff0000u);
    f[4] = __uint_as_float(w.z << 16); f[5] = __uint_as_float(w.z & 0xffff0000u);
    f[6] = __uint_as_float(w.w << 16); f[7] = __uint_as_float(w.w & 0xffff0000u);
}
__device__ __forceinline__ float shx(float v, int mask, int lane) { return __int_as_float(__builtin_amdgcn_ds_bpermute((lane ^ mask) << 2, __float_as_int(v))); }

__constant__ double c_invfreq[32] = {1.0, 0.7498942093324559, 0.5623413251903491, 0.4216965034285822, 0.31622776601683794, 0.23713737056616552, 0.1778279410038923, 0.1333521432163324, 0.1, 0.07498942093324558, 0.05623413251903491, 0.042169650342858224, 0.03162277660168379, 0.023713737056616554, 0.01778279410038923, 0.01333521432163324, 0.01, 0.007498942093324558, 0.005623413251903491, 0.004216965034285823, 0.0031622776601683794, 0.0023713737056616554, 0.0017782794100389228, 0.001333521432163324, 0.001, 0.0007498942093324559, 0.0005623413251903491, 0.00042169650342858224, 0.00031622776601683794, 0.00023713737056616554, 0.00017782794100389227, 0.0001333521432163324};

__device__ __forceinline__ void sincos_d(double a, float& s, float& c) {
    const double n = rint(a * 0.15915494309189535);
    double r = fma(-n, 6.283185307179586, a);
    r = fma(-n, 2.4492935982947064e-16, r);
    const double h = 0.5 * r, h2 = h * h;
    double sp = 1.0 / 355687428096000.0;
    sp = fma(sp, h2, -1.0 / 1307674368000.0); sp = fma(sp, h2, 1.0 / 6227020800.0); sp = fma(sp, h2, -1.0 / 39916800.0);
    sp = fma(sp, h2, 1.0 / 362880.0); sp = fma(sp, h2, -1.0 / 5040.0); sp = fma(sp, h2, 1.0 / 120.0); sp = fma(sp, h2, -1.0 / 6.0); sp = fma(sp, h2, 1.0);
    const double sh = sp * h;
    double cp = 1.0 / 20922789888000.0;
    cp = fma(cp, h2, -1.0 / 87178291200.0); cp = fma(cp, h2, 1.0 / 479001600.0); cp = fma(cp, h2, -1.0 / 3628800.0);
    cp = fma(cp, h2, 1.0 / 40320.0); cp = fma(cp, h2, -1.0 / 720.0); cp = fma(cp, h2, 1.0 / 24.0); cp = fma(cp, h2, -0.5); cp = fma(cp, h2, 1.0);
    s = (float)(2.0 * sh * cp); c = (float)(1.0 - 2.0 * sh * sh);
}

template <int MAP> __device__ __forceinline__ int colmap(int p) {
    if (MAP == 1) {
        if (p >= 2304) return p;
        const int rem = p % 768, part = rem >> 8;
        if (part == 2) return p;
        const int dd = p & 63, d = (dd & 1) ? (dd >> 1) + 32 : (dd >> 1);
        return (p & ~63) + d;
    } else if (MAP == 2) {
        return ((p & 255) >> 7) * 1024 + (p >> 8) * 128 + (p & 127);
    }
    return p;
}
template <int MAP> __device__ __forceinline__ void transpose_item(const float* __restrict__ W, int ldw, int coloff, int K, bf16_t* __restrict__ WT, int item, int nblk, float* scr, int lane) {
    const int kb = item / nblk, nb = item % nblk, k0 = 64 * kb, n0 = 32 * nb;
    if (MAP == 1) {
        const int srcc = coloff + colmap<MAP>(n0 + (lane & 31));
#pragma unroll 8
        for (int i = 0; i < 32; ++i) { const int kk = 2 * i + (lane >> 5); scr[kk * 33 + (lane & 31)] = W[(size_t)(k0 + kk) * ldw + srcc]; }
    } else {
        const int c4 = (lane & 7) * 4, srcc = coloff + colmap<MAP>(n0 + c4);
        f32x4 v[8];
#pragma unroll
        for (int i = 0; i < 8; ++i) v[i] = __builtin_nontemporal_load((const f32x4*)(W + (size_t)(k0 + 8 * i + (lane >> 3)) * ldw + srcc));
#pragma unroll
        for (int i = 0; i < 8; ++i) { float* d = scr + (8 * i + (lane >> 3)) * 33 + c4; d[0] = v[i].x; d[1] = v[i].y; d[2] = v[i].z; d[3] = v[i].w; }
    }
    asm volatile("s_waitcnt lgkmcnt(0)" ::: "memory");
    const int c = lane & 7;
#pragma unroll
    for (int j = 0; j < 4; ++j) { const int n = (lane >> 3) + 8 * j; const float* s = scr + (8 * c) * 33 + n;
        u32x4 o; o.x = pk2(s[0 * 33], s[1 * 33]); o.y = pk2(s[2 * 33], s[3 * 33]); o.z = pk2(s[4 * 33], s[5 * 33]); o.w = pk2(s[6 * 33], s[7 * 33]);
        __builtin_nontemporal_store(o, (u32x4*)(WT + (size_t)(n0 + n) * K + k0 + 8 * c)); }
    asm volatile("s_waitcnt lgkmcnt(0)" ::: "memory");
}
#define EPI_ROW(ai, m) ((ai) * 128 + wr * 64 + (m) * 16 + fr)
#define EPI_COL(bj, n) ((bj) * 128 + wc * 32 + (n) * 16 + 4 * fq)
#define EPI_COLP(bj) ((bj) * 128 + wc * 32 + 8 * fq)
__device__ __forceinline__ u32x4 pk8(const f32x4 a, const f32x4 b) { return (u32x4){pk2(a.x, a.y), pk2(a.z, a.w), pk2(b.x, b.y), pk2(b.z, b.w)}; }
struct EpiInA { bf16_t* out;
    static constexpr bool PERM = true;
    template <class U> __device__ __forceinline__ void tile(const U& u, const f32x4 (&acc)[2][2][4][2], int wr, int wc, int fr, int fq) const {
#pragma unroll
        for (int bj = 0; bj < 2; ++bj) {
            const int p = u.col0 + EPI_COLP(bj); const int part = (p < 2304) ? ((p % 768) >> 8) : 3;
            const int j0 = (p & 63) >> 1; float f[4];
#pragma unroll
            for (int i = 0; i < 4; ++i) f[i] = __builtin_amdgcn_exp2f(-(float)(j0 + i) * 0.41524101186092034f) * 0.15915494309189535f;
#pragma unroll
            for (int ai = 0; ai < 2; ++ai)
#pragma unroll
                for (int m = 0; m < 4; ++m) { const int row = u.row0 + EPI_ROW(ai, m); f32x4 v[2] = {acc[ai][bj][m][0], acc[ai][bj][m][1]};
                    if (part < 2) { const float pos = (float)(row & (SEQ - 1));
#pragma unroll
                        for (int n = 0; n < 2; ++n) { const float t0 = __builtin_amdgcn_fractf(pos * f[2 * n]), t1 = __builtin_amdgcn_fractf(pos * f[2 * n + 1]);
                            const float c0 = __builtin_amdgcn_cosf(t0), s0 = __builtin_amdgcn_sinf(t0), c1 = __builtin_amdgcn_cosf(t1), s1 = __builtin_amdgcn_sinf(t1);
                            f32x4 o; o.x = v[n].x * c0 - v[n].y * s0; o.y = v[n].y * c0 + v[n].x * s0; o.z = v[n].z * c1 - v[n].w * s1; o.w = v[n].w * c1 + v[n].z * s1; v[n] = o; } }
                    if (part == 0 || part == 3) { v[0] = v[0] * C2; v[1] = v[1] * C2; }
                    const int bb = row >> 11, t = row & (SEQ - 1); size_t off;
                    if (part == 3) off = LA_QM + ((size_t)((bb * 4 + ((p - 2304) >> 6)) * SEQ + t) << 6) + (p & 63);
                    else { const int g = p / 768, hh = ((p - g * 768) >> 6) & 3, dsh = 2 * g, gb = (g * 8 + bb) * 4 + hh;
                        if (part == 0) off = ((size_t)((gb * 16 + (t & 15)) * 128 + (t >> 4)) << 6) + (p & 63);
                        else off = LA_K * part + ((size_t)(gb * SEQ + (t & ((1 << dsh) - 1)) * (SEQ >> dsh) + (t >> dsh)) << 6) + (p & 63); }
                    *(u32x4*)(out + off) = pk8(v[0], v[1]); }
        }
    } };
struct EpiInB { bf16_t* out;
    static constexpr bool PERM = true;
    template <class U> __device__ __forceinline__ void tile(const U& u, const f32x4 (&acc)[2][2][4][2], int wr, int wc, int fr, int fq) const {
#pragma unroll
        for (int ai = 0; ai < 2; ++ai)
#pragma unroll
            for (int m = 0; m < 4; ++m) { const int row = u.row0 + EPI_ROW(ai, m);
#pragma unroll
                for (int bj = 0; bj < 2; ++bj) { const int p = u.col0 + EPI_COLP(bj); const float sc = (p >= 1536) ? C2 : 1.0f;
                    const int reg = p >= 2304 ? 3 : p / 768, pc = p - reg * 768, nh = reg == 3 ? 4 : NFOX, bb = row >> 11, t = row & (SEQ - 1);
                    *(u32x4*)(out + (size_t)reg * LB_V + ((size_t)((bb * nh + (pc >> 6)) * SEQ + t) << 6) + (pc & 63)) = pk8(acc[ai][bj][m][0] * sc, acc[ai][bj][m][1] * sc); } }
    } };
struct EpiPlain { bf16_t* out; int ld; int pad;
    static constexpr bool PERM = true;
    template <class U> __device__ __forceinline__ void tile(const U& u, const f32x4 (&acc)[2][2][4][2], int wr, int wc, int fr, int fq) const {
#pragma unroll
        for (int ai = 0; ai < 2; ++ai)
#pragma unroll
            for (int m = 0; m < 4; ++m) { const int row = u.row0 + EPI_ROW(ai, m);
#pragma unroll
                for (int bj = 0; bj < 2; ++bj) *(u32x4*)(out + (size_t)row * ld + u.col0 + EPI_COLP(bj)) = pk8(acc[ai][bj][m][0], acc[ai][bj][m][1]); }
    } };
struct EpiOut { float* pre; const float* res;
    static constexpr bool PERM = false;
    template <class U> __device__ __forceinline__ void tile(const U& u, const f32x4 (&acc)[2][2][4][2], int wr, int wc, int fr, int fq) const {
#pragma unroll
        for (int ai = 0; ai < 2; ++ai) {
            f32x4 x[4][2][2];
#pragma unroll
            for (int m = 0; m < 4; ++m)
#pragma unroll
                for (int bj = 0; bj < 2; ++bj)
#pragma unroll
                    for (int n = 0; n < 2; ++n) x[m][bj][n] = *(const f32x4*)(res + (size_t)(u.row0 + EPI_ROW(ai, m)) * DM + u.col0 + EPI_COL(bj, n));
#pragma unroll
            for (int m = 0; m < 4; ++m)
#pragma unroll
                for (int bj = 0; bj < 2; ++bj)
#pragma unroll
                    for (int n = 0; n < 2; ++n) *(f32x4*)(pre + (size_t)(u.row0 + EPI_ROW(ai, m)) * DM + u.col0 + EPI_COL(bj, n)) = x[m][bj][n] * DN_ALPHA + acc[ai][bj][m][n];
        }
    } };
struct EpiGU { bf16_t* act; const float* bgu;
    static constexpr bool PERM = true;
    template <class U> __device__ __forceinline__ void tile(const U& u, const f32x4 (&acc)[2][2][4][2], int wr, int wc, int fr, int fq) const {
        f32x4 bg[2], bu[2]; const int j = u.col0 + EPI_COLP(0);
        float ka = -SW_ALPHA * LOG2E, k1 = 1.0f; asm volatile("" : "+v"(ka), "+v"(k1));
        const f32x2 KA = {ka, ka}, K1 = {k1, k1};
#pragma unroll
        for (int n = 0; n < 2; ++n) { bg[n] = *(const f32x4*)(bgu + (size_t)u.e * 2048 + j + 4 * n); bu[n] = *(const f32x4*)(bgu + (size_t)u.e * 2048 + 1024 + j + 4 * n); }
#pragma unroll
        for (int ai = 0; ai < 2; ++ai)
#pragma unroll
            for (int m = 0; m < 4; ++m) { const int row = u.row0 + EPI_ROW(ai, m); f32x4 o[2];
#pragma unroll
                for (int n = 0; n < 2; ++n) { const f32x4 g = acc[ai][0][m][n], up = acc[ai][1][m][n];
#pragma unroll
                    for (int i = 0; i < 4; i += 2) {
                        f32x2 G = (f32x2){g[i], g[i + 1]} + (f32x2){bg[n][i], bg[n][i + 1]}, Uv = (f32x2){up[i], up[i + 1]} + (f32x2){bu[n][i], bu[n][i + 1]};
                        G.x = fminf(G.x, SW_LIMIT); G.y = fminf(G.y, SW_LIMIT);
                        Uv.x = __builtin_amdgcn_fmed3f(Uv.x, -SW_LIMIT, SW_LIMIT); Uv.y = __builtin_amdgcn_fmed3f(Uv.y, -SW_LIMIT, SW_LIMIT);
                        const f32x2 T = G * KA;
                        const f32x2 D = (f32x2){__builtin_amdgcn_exp2f(T.x), __builtin_amdgcn_exp2f(T.y)} + K1;
                        const f32x2 R = {__builtin_amdgcn_rcpf(D.x), __builtin_amdgcn_rcpf(D.y)};
                        const f32x2 O = __builtin_elementwise_fma(Uv, G, G) * R;
                        o[n][i] = O.x; o[n][i + 1] = O.y; } }
                *(u32x4*)(act + (size_t)row * DFF + j) = pk8(o[0], o[1]); }
    } };
struct EpiDN { bf16_t* y; const float* bdn; const float* rowgate;
    static constexpr bool PERM = true;
    template <class U> __device__ __forceinline__ void tile(const U& u, const f32x4 (&acc)[2][2][4][2], int wr, int wc, int fr, int fq) const {
        f32x4 b[2][2]; float g[2][4];
#pragma unroll
        for (int bj = 0; bj < 2; ++bj)
#pragma unroll
            for (int n = 0; n < 2; ++n) b[bj][n] = *(const f32x4*)(bdn + (size_t)u.e * DM + u.col0 + EPI_COLP(bj) + 4 * n);
#pragma unroll
        for (int ai = 0; ai < 2; ++ai)
#pragma unroll
            for (int m = 0; m < 4; ++m) g[ai][m] = rowgate[(size_t)u.e * ECAP + u.idx0 + EPI_ROW(ai, m)];
#pragma unroll
        for (int ai = 0; ai < 2; ++ai)
#pragma unroll
            for (int m = 0; m < 4; ++m) { const int row = u.row0 + EPI_ROW(ai, m);
#pragma unroll
                for (int bj = 0; bj < 2; ++bj) *(u32x4*)(y + (size_t)row * DM + u.col0 + EPI_COLP(bj)) = pk8((acc[ai][bj][m][0] + b[bj][0]) * g[ai][m], (acc[ai][bj][m][1] + b[bj][1]) * g[ai][m]); }
    } };

namespace fg {
#define FG_LAS __attribute__((address_space(3)))
typedef short bf16x8 __attribute__((ext_vector_type(8)));
constexpr int BM = 256, BK = 64, HALF = 128, HTB = HALF * BK * 2, STAGE_BYTES = 8 * HTB, NXCD = 8, WGM = 8;
constexpr int GIDX_OFF = 131072 + 10240;
__host__ __device__ __forceinline__ int lds_byte(int r, int c) { const int st = (r >> 4) * 2 + (c >> 5), rr = r & 15, cc = c & 31, ob = rr * 64 + cc * 2; return st * 1024 + (ob ^ (((ob >> 9) & 1) << 5)); }
__host__ __device__ __forceinline__ void stage_rc(int b, int& R, int& C) { const int st = b / 1024, sb = b % 1024, swz = sb ^ (((sb >> 9) & 1) << 5); R = (st >> 1) * 16 + swz / 64; C = (st & 1) * 32 + (swz % 64) / 2; }

struct FUnit { const bf16_t* B;
               const int* gather; int gcount;
               int arow0;
               int row0, col0, e, idx0; };

struct DenseSched {
    const bf16_t* Bt; int K, nM, nN, nwg, G, c;
    __device__ void init(const bf16_t* Bt_, int M, int N, int K_, int G_, int c_) { Bt = Bt_; K = K_; nM = M / BM; nN = N / BM; nwg = nM * nN; G = G_; c = c_; }
    __device__ __forceinline__ bool next(int i, FUnit& u, int) const {
        const long L = (long)i * G + c; if (L >= nwg) return false;
        int wgid = (int)L; { const int q = nwg / NXCD, r = nwg % NXCD, xcd = wgid % NXCD, off = wgid / NXCD; wgid = (xcd < r ? xcd * (q + 1) : r * (q + 1) + (xcd - r) * q) + off; }
        const int nig = WGM * nN, gid = wgid / nig, fm = gid * WGM, gsz = (nM - fm) < WGM ? (nM - fm) : WGM;
        const int pm = fm + ((wgid % nig) % gsz), pn = (wgid % nig) / gsz;
        u.B = Bt + (size_t)pn * BM * K; u.gather = nullptr; u.gcount = 0; u.arow0 = pm * BM; u.row0 = pm * BM; u.col0 = pn * BM; u.e = 0; u.idx0 = 0; return true;
    }
};
template <int DUAL> struct MoeSched {
    const bf16_t* Wt; const unsigned* cnt; const int* rowtok; const FG_LAS int* pre;
    int G, vcu;
    static constexpr int TN = DUAL ? 8 : 4;
    __device__ __forceinline__ bool next(int i, FUnit& u, int lane) const {
        const int L = i * G + vcu; if (L >= pre[NEXP]) return false;
        const int pv = pre[lane < NEXP ? lane : NEXP];
        const int e = __builtin_popcountll(__ballot(lane < NEXP && L >= pv)) - 1;
        const int loc = L - pre[e], J = (pre[e + 1] - pre[e]) / TN;
        int j, nt; if (DUAL) { const int g = loc / (4 * J), r = loc % (4 * J); j = r >> 2; nt = g * 4 + (r & 3); } else { j = loc >> 2; nt = loc & 3; }
        const int mt = pre[e] / TN + j, c = (int)cnt[e];
        if (DUAL) { u.B = Wt + ((size_t)e * 2048 + nt * 256) * DM; u.gather = rowtok + (size_t)e * ECAP + j * BM; u.gcount = c - j * BM; u.arow0 = 0; u.col0 = nt * 128; }
        else { u.B = Wt + ((size_t)e * 1024 + nt * 256) * DFF; u.gather = nullptr; u.gcount = 0; u.arow0 = mt * BM; u.col0 = nt * 256; }
        u.row0 = mt * BM; u.e = e; u.idx0 = j * BM; return true;
    }
};
__device__ __forceinline__ void moe_prefix(const unsigned* cnt, FG_LAS int* pre, int TN, int tid) {
    if (tid == 0) { int acc = 0; for (int e = 0; e < NEXP; ++e) { pre[e] = acc; acc += (((int)cnt[e] + BM - 1) / BM) * TN; } pre[NEXP] = acc; }
    __syncthreads();
}

template <int DUAL, class Epi, class Sched>
__device__ __forceinline__ void gemm_phase(FG_LAS unsigned char* lds, const bf16_t* A, int K, const Sched& S, const Epi& E, const int tid) {
    const int wid = __builtin_amdgcn_readfirstlane(tid >> 6), lane = tid & 63, wr = wid >> 2, wc = wid & 3, fr = lane & 15, fq = lane >> 4;
    const int nt = K / BK;
    int Rr[2], Cc[2]; unsigned voffB[2];
#pragma unroll
    for (int i = 0; i < 2; ++i) { stage_rc(tid * 16 + i * 8192, Rr[i], Cc[i]);
        const int rho = Rr[i] & 31, Rb = Epi::PERM ? ((Rr[i] & ~31) + 8 * ((rho & 15) >> 2) + 4 * (rho >> 4) + (rho & 3)) : Rr[i];
        voffB[i] = (unsigned)(Rb * K + Cc[i]) * 2u; }
    const size_t kstep = (size_t)(BK * 2);
    const size_t hstep = (size_t)HALF * K * 2;
    const unsigned ldsw = (unsigned)wid * 1024u;
    const int aoff = lds_byte(wr * 64 + fr, fq * 8), boff = lds_byte(wc * 32 + fr, fq * 8);
#define FG_SA(b, h) (((b) * 2 + (h)) * HTB)
#define FG_SB(b, h) ((4 + (b) * 2 + (h)) * HTB)
#define FG_STAGEB(bufoff, gbase) do { _Pragma("unroll") for (int _i = 0; _i < 2; ++_i) \
        __builtin_amdgcn_global_load_lds((const unsigned*)((const char*)(gbase) + voffB[_i]), (FG_LAS unsigned*)(lds + (bufoff) + ldsw + _i * 8192), 16, 0, 0); } while (0)
#define FG_STAGEA(bufoff, o0, o1, kb) do { \
        __builtin_amdgcn_global_load_lds((const unsigned*)((const char*)A + (size_t)(o0) + (kb)), (FG_LAS unsigned*)(lds + (bufoff) + ldsw), 16, 0, 0); \
        __builtin_amdgcn_global_load_lds((const unsigned*)((const char*)A + (size_t)(o1) + (kb)), (FG_LAS unsigned*)(lds + (bufoff) + ldsw + 8192), 16, 0, 0); } while (0)
#define FG_LDA(dst, b, h) do { _Pragma("unroll") for (int m = 0; m < 4; ++m) _Pragma("unroll") for (int k = 0; k < 2; ++k) dst[m][k] = *(const FG_LAS bf16x8*)(lds + FG_SA(b, h) + aoff + m * 2048 + k * 1024); } while (0)
#define FG_LDB(dst, b, h) do { _Pragma("unroll") for (int n = 0; n < 2; ++n) _Pragma("unroll") for (int k = 0; k < 2; ++k) dst[n][k] = *(const FG_LAS bf16x8*)(lds + FG_SB(b, h) + boff + n * 2048 + k * 1024); } while (0)
#define FG_MMA(ai, bj, At, Bt) do { __builtin_amdgcn_s_setprio(1); _Pragma("unroll") for (int m = 0; m < 4; ++m) _Pragma("unroll") for (int n = 0; n < 2; ++n) _Pragma("unroll") for (int k = 0; k < 2; ++k) \
        acc[ai][bj][m][n] = __builtin_amdgcn_mfma_f32_16x16x32_bf16(Bt[n][k], At[m][k], acc[ai][bj][m][n], 0, 0, 0); __builtin_amdgcn_s_setprio(0); } while (0)
#define FG_WAIT_V(n) asm volatile("s_waitcnt vmcnt(" #n ")" ::: "memory")
#define FG_WAIT_L(n) asm volatile("s_waitcnt lgkmcnt(" #n ")" ::: "memory")
#define FG_BAR __builtin_amdgcn_s_barrier()
#define FG_SCHED __builtin_amdgcn_sched_barrier(0)
#define FG_AOFFS(u, dst) do { _Pragma("unroll") for (int h = 0; h < 2; ++h) _Pragma("unroll") for (int i = 0; i < 2; ++i) { const int r_ = h * HALF + Rr[i]; int row_; \
        if ((u).gather) row_ = (r_ < (u).gcount) ? (u).gather[r_] : 0; else row_ = (u).arow0 + r_; dst[h][i] = (unsigned)(row_ * K + Cc[i]) * 2u; } } while (0)
    FUnit cur, nxt; int ui = 0;
    if (!S.next(0, cur, lane)) return;
#ifndef FG_KREP
#define FG_KREP 1
#endif
    f32x4 acc[2][2][4][2];
#pragma unroll
    for (int a = 0; a < 2; ++a)
#pragma unroll
        for (int b = 0; b < 2; ++b)
#pragma unroll
            for (int m = 0; m < 4; ++m)
#pragma unroll
                for (int n = 0; n < 2; ++n) acc[a][b][m][n] = (f32x4){0.f, 0.f, 0.f, 0.f};
    bf16x8 At[4][2], B0[2][2], B1[2][2];
    unsigned ao[2][2], an[2][2];
    FG_AOFFS(cur, ao);
    const char* cB = (const char*)cur.B;
    FG_STAGEB(FG_SB(0, 0), cB); FG_STAGEB(FG_SB(0, 1), cB + hstep); FG_STAGEA(FG_SA(0, 0), ao[0][0], ao[0][1], 0); FG_STAGEA(FG_SA(0, 1), ao[1][0], ao[1][1], 0);
    if (wr == 1) FG_BAR;
    FG_WAIT_V(2); FG_BAR;
    FG_STAGEB(FG_SB(1, 0), cB + kstep); FG_STAGEA(FG_SA(1, 0), ao[0][0], ao[0][1], kstep); FG_STAGEB(FG_SB(1, 1), cB + hstep + kstep);
    FG_WAIT_V(6); FG_BAR;
    for (;;) {
        const bool has_next = S.next((ui + 1) / FG_KREP, nxt, lane);
        const bool nx_gather = has_next && nxt.gather != nullptr;
        if (nx_gather) { if (wid == 0) __builtin_amdgcn_global_load_lds((const unsigned*)(nxt.gather + lane * 4), (FG_LAS unsigned*)(lds + GIDX_OFF), 16, 0, 0); }
        else if (has_next) { FG_AOFFS(nxt, an); } else {
#pragma unroll
            for (int h = 0; h < 2; ++h)
#pragma unroll
                for (int i = 0; i < 2; ++i) an[h][i] = ao[h][i]; }
        const char* nB = has_next ? (const char*)nxt.B : cB;
        for (int t = 0; t < nt; t += 2) {
            const bool last = (t == nt - 2);
            const size_t k1 = (size_t)(t + 1) * kstep, k2 = last ? 0 : (size_t)(t + 2) * kstep, k3 = k2 + kstep;
            const char* b2 = (last ? nB : cB) + k2; const char* b3 = b2 + kstep;
            if (last && nx_gather) {
#pragma unroll
                for (int h = 0; h < 2; ++h)
#pragma unroll
                    for (int i = 0; i < 2; ++i) { const int r_ = h * HALF + Rr[i]; const int row_ = (r_ < nxt.gcount) ? *(const FG_LAS int*)(lds + GIDX_OFF + r_ * 4) : 0; an[h][i] = (unsigned)(row_ * K + Cc[i]) * 2u; } }
            const unsigned s00 = last ? an[0][0] : ao[0][0], s01 = last ? an[0][1] : ao[0][1], s10 = last ? an[1][0] : ao[1][0], s11 = last ? an[1][1] : ao[1][1];
            FG_LDB(B0, 0, 0); FG_LDB(B1, 0, 1); FG_SCHED; FG_LDA(At, 0, 0); FG_STAGEA(FG_SA(1, 1), ao[1][0], ao[1][1], k1);
            FG_WAIT_V(8); FG_WAIT_L(0); FG_BAR; FG_MMA(0, 0, At, B0); FG_MMA(0, 1, At, B1); FG_BAR; FG_SCHED;
            FG_LDA(At, 0, 1); FG_STAGEB(FG_SB(0, 0), b2); FG_STAGEB(FG_SB(0, 1), b2 + hstep); FG_STAGEA(FG_SA(0, 0), s00, s01, k2);
            FG_WAIT_V(8); FG_WAIT_L(0); FG_BAR; FG_MMA(1, 0, At, B0); FG_MMA(1, 1, At, B1); FG_BAR; FG_SCHED;
            FG_LDB(B0, 1, 0); FG_LDB(B1, 1, 1); FG_SCHED; FG_LDA(At, 1, 0); FG_STAGEA(FG_SA(0, 1), s10, s11, k2);
            FG_WAIT_V(8); FG_WAIT_L(0); FG_BAR; FG_MMA(0, 0, At, B0); FG_MMA(0, 1, At, B1); FG_BAR; FG_SCHED;
            FG_LDA(At, 1, 1); FG_STAGEB(FG_SB(1, 0), b3); FG_STAGEB(FG_SB(1, 1), b3 + hstep); FG_STAGEA(FG_SA(1, 0), s00, s01, k3);
            FG_WAIT_V(8); FG_WAIT_L(0); FG_BAR; FG_MMA(1, 0, At, B0); FG_MMA(1, 1, At, B1); FG_BAR; FG_SCHED;
        }
        if (wr == 0) FG_BAR;
        if (ui % FG_KREP == FG_KREP - 1) E.tile(cur, acc, wr, wc, fr, fq);
        if (!has_next) break;
#pragma unroll
        for (int a = 0; a < 2; ++a)
#pragma unroll
            for (int b = 0; b < 2; ++b)
#pragma unroll
                for (int m = 0; m < 4; ++m)
#pragma unroll
                    for (int n = 0; n < 2; ++n) acc[a][b][m][n] = (f32x4){0.f, 0.f, 0.f, 0.f};
        cur = nxt; cB = nB; ++ui;
#pragma unroll
        for (int h = 0; h < 2; ++h)
#pragma unroll
            for (int i = 0; i < 2; ++i) ao[h][i] = an[h][i];
        if (wr == 1) FG_BAR;
    }
    FG_WAIT_V(0);
    FG_BAR;
#undef FG_SA
#undef FG_SB
#undef FG_STAGEA
#undef FG_STAGEB
#undef FG_LDA
#undef FG_LDB
#undef FG_MMA
#undef FG_WAIT_V
#undef FG_WAIT_L
#undef FG_BAR
#undef FG_SCHED
#undef FG_AOFFS
}
}
constexpr int FAST_LDS = 147456;
constexpr int MISC_OFF = 131072;
__device__ __forceinline__ int vcu_of(int bx, int G) { return (G % 8 == 0) ? (bx % 8) * (G / 8) + bx / 8 : bx; }

namespace at {
#define AT_LAS __attribute__((address_space(3)))
typedef short bf16x8 __attribute__((ext_vector_type(8)));
typedef short s16x4 __attribute__((ext_vector_type(4)));
typedef short v4i16_t __attribute__((ext_vector_type(4)));
typedef float f32x16 __attribute__((ext_vector_type(16)));
typedef __bf16 bf16x2_t __attribute__((ext_vector_type(2)));
__device__ __forceinline__ unsigned cvtpk(float lo, float hi) { f32x2 v = {lo, hi}; bf16x2_t b = __builtin_convertvector(v, bf16x2_t); return __builtin_bit_cast(unsigned, b); }
__device__ __forceinline__ s16x4 vtr(const AT_LAS char* p) { return __builtin_bit_cast(s16x4, __builtin_amdgcn_ds_read_tr16_b64_v4i16((AT_LAS v4i16_t*)p)); }
__device__ __forceinline__ void glds16(const void* g, AT_LAS char* l) { unsigned keep; const unsigned dst = (unsigned)__builtin_amdgcn_readfirstlane((int)(unsigned)(uintptr_t)l);
    asm volatile("s_mov_b32 %0, m0\n\ts_mov_b32 m0, %2\n\ts_nop 0\n\tglobal_load_lds_dwordx4 %1, off\n\ts_mov_b32 m0, %0" : "=&s"(keep) : "v"(g), "s"(dst) : "memory"); }
__device__ __forceinline__ void glds16x4(unsigned voff, const void* sbase, AT_LAS char* l) { unsigned keep; const unsigned dst = (unsigned)__builtin_amdgcn_readfirstlane((int)(unsigned)(uintptr_t)l);
    asm volatile("s_mov_b32 %0, m0\n\ts_mov_b32 m0, %3\n\ts_nop 0\n\tglobal_load_lds_dwordx4 %1, %2\n\tglobal_load_lds_dwordx4 %1, %2 offset:1024\n\tglobal_load_lds_dwordx4 %1, %2 offset:2048\n\tglobal_load_lds_dwordx4 %1, %2 offset:3072\n\ts_mov_b32 m0, %0"
                 : "=&s"(keep) : "v"(voff), "s"(sbase), "s"(dst) : "memory"); }
__device__ __forceinline__ void glds16x2(unsigned voff, const void* sbase, AT_LAS char* l) { unsigned keep; const unsigned dst = (unsigned)__builtin_amdgcn_readfirstlane((int)(unsigned)(uintptr_t)l);
    asm volatile("s_mov_b32 %0, m0\n\ts_mov_b32 m0, %3\n\ts_nop 0\n\tglobal_load_lds_dwordx4 %1, %2\n\tglobal_load_lds_dwordx4 %1, %2 offset:2048\n\ts_mov_b32 m0, %0"
                 : "=&s"(keep) : "v"(voff), "s"(sbase), "s"(dst) : "memory"); }
__device__ __forceinline__ float swapmax(float x) { auto rr = __builtin_amdgcn_permlane32_swap(__float_as_uint(x), __float_as_uint(x), false, false); return fmaxf(__uint_as_float(rr[0]), __uint_as_float(rr[1])); }
__device__ __forceinline__ float swapsum(float x) { auto rr = __builtin_amdgcn_permlane32_swap(__float_as_uint(x), __float_as_uint(x), false, false); return __uint_as_float(rr[0]) + __uint_as_float(rr[1]); }
__device__ __forceinline__ f32x16 qk32(const AT_LAS char* kblk, const bf16x8 (&qr)[4], int r32, int hi) {
    bf16x8 a[4]; const AT_LAS char* rp = kblk + r32 * 128; const int x = r32 & 7;
#pragma unroll
    for (int d0 = 0; d0 < 4; ++d0) a[d0] = *(const AT_LAS bf16x8*)(rp + (((2 * d0 + hi) ^ x) << 4));
    f32x16 p = {};
#pragma unroll
    for (int d0 = 0; d0 < 4; ++d0) p = __builtin_amdgcn_mfma_f32_32x32x16_bf16(a[d0], qr[d0], p, 0, 0, 0);
    return p;
}
__device__ __forceinline__ void qk64(f32x16& p0, f32x16& p1, const AT_LAS char* kt, const bf16x8 (&qr)[4], int r32, int hi) {
    bf16x8 a[4], b[4]; const AT_LAS char* rp = kt + r32 * 128; const int x = r32 & 7;
#pragma unroll
    for (int d0 = 0; d0 < 4; ++d0) { const int so = ((2 * d0 + hi) ^ x) << 4; a[d0] = *(const AT_LAS bf16x8*)(rp + so); b[d0] = *(const AT_LAS bf16x8*)(rp + 4096 + so); }
    p0 = f32x16{}; p1 = f32x16{};
#pragma unroll
    for (int d0 = 0; d0 < 4; ++d0) { p0 = __builtin_amdgcn_mfma_f32_32x32x16_bf16(a[d0], qr[d0], p0, 0, 0, 0); p1 = __builtin_amdgcn_mfma_f32_32x32x16_bf16(b[d0], qr[d0], p1, 0, 0, 0); }
}
__device__ __forceinline__ void pack_p(const f32x16& p, bf16x8& pa0, bf16x8& pa1) {
    u32x4 w0, w1;
    w0.x = cvtpk(p[0], p[1]); w0.y = cvtpk(p[2], p[3]); w0.z = cvtpk(p[4], p[5]); w0.w = cvtpk(p[6], p[7]);
    w1.x = cvtpk(p[8], p[9]); w1.y = cvtpk(p[10], p[11]); w1.z = cvtpk(p[12], p[13]); w1.w = cvtpk(p[14], p[15]);
    pa0 = __builtin_bit_cast(bf16x8, w0); pa1 = __builtin_bit_cast(bf16x8, w1);
}
__device__ __forceinline__ void v_lane_offs(int lane, int hi, int (&a)[2]) {
    const int q = (lane & 15) >> 2, cl = 2 * ((lane >> 4) & 1) + ((lane & 3) >> 1), sub = (lane & 1) * 8;
#pragma unroll
    for (int sec = 0; sec < 2; ++sec) { const int kl = 4 * hi + q + 8 * sec; a[sec] = kl * 128 + ((cl ^ ((kl >> 1) & 7)) << 4) + sub; }
}
template <int NKS> __device__ __forceinline__ void pv_tile(f32x16 (&o)[2], const bf16x8 (&pa)[NKS], const AT_LAS char* vt, int lane, int hi) {
    int a[2]; v_lane_offs(lane, hi, a);
    s16x4 lo[2][NKS], hh[2][NKS];
#pragma unroll
    for (int d0 = 0; d0 < 2; ++d0)
#pragma unroll
        for (int ks = 0; ks < NKS; ++ks) { lo[d0][ks] = vtr(vt + ks * 2048 + (a[0] ^ (d0 * 64))); hh[d0][ks] = vtr(vt + ks * 2048 + (a[1] ^ (d0 * 64))); }
#pragma unroll
    for (int ks = 0; ks < NKS; ++ks)
#pragma unroll
        for (int d0 = 0; d0 < 2; ++d0) { const bf16x8 b = (bf16x8){lo[d0][ks][0], lo[d0][ks][1], lo[d0][ks][2], lo[d0][ks][3], hh[d0][ks][0], hh[d0][ks][1], hh[d0][ks][2], hh[d0][ks][3]};
            o[d0] = __builtin_amdgcn_mfma_f32_32x32x16_bf16(pa[ks], b, o[d0], 0, 0, 0); }
}
__device__ __forceinline__ void pv32(f32x16 (&o)[2], const f32x16& p, const AT_LAS char* vt, int lane, int hi) { bf16x8 pa[2]; pack_p(p, pa[0], pa[1]); pv_tile<2>(o, pa, vt, lane, hi); }
__device__ __forceinline__ void pv64(f32x16 (&o)[2], const f32x16& p0, const f32x16& p1, const AT_LAS char* vt, int lane, int hi) { bf16x8 pa[4]; pack_p(p0, pa[0], pa[1]); pack_p(p1, pa[2], pa[3]); pv_tile<4>(o, pa, vt, lane, hi); }
template <int NBK> __device__ __forceinline__ void softmax_step(f32x16 (&p)[NBK], float& m, float& l, f32x16 (&o)[2], AT_LAS float* wsf, int r32, int hi) {
    float mt = p[0][0];
#pragma unroll
    for (int b = 0; b < NBK; ++b)
#pragma unroll
        for (int r = 0; r < 16; ++r) mt = fmaxf(mt, p[b][r]);
    mt = swapmax(mt);
    const float mn = fmaxf(m, mt);
    if (__any(mt > m + 4.0f)) {
        const float alpha = __builtin_amdgcn_exp2f(m - mn);
        l *= alpha;
        if (hi == 0) wsf[r32] = alpha;
#pragma unroll
        for (int g = 0; g < 4; ++g) { const f32x4 a = *(const AT_LAS f32x4*)(wsf + 8 * g + 4 * hi);
#pragma unroll
            for (int i = 0; i < 4; ++i) { o[0][4 * g + i] *= a[i]; o[1][4 * g + i] *= a[i]; } }
        m = mn;
    }
    float s = 0.f;
#pragma unroll
    for (int b = 0; b < NBK; ++b)
#pragma unroll
        for (int r = 0; r < 16; ++r) { p[b][r] = __builtin_amdgcn_exp2f(p[b][r] - m); s += p[b][r]; }
    l += s;
}
__device__ __forceinline__ void attn_store(const f32x16 (&o)[2], float l, AT_LAS float* wsf, AT_LAS bf16_t* stg, bf16_t* Og, size_t rs, int lane, int r32, int hi) {
    const float lt = swapsum(l);
    if (hi == 0) wsf[32 + r32] = 1.0f / lt;
#pragma unroll
    for (int g = 0; g < 4; ++g) { const f32x4 rl = *(const AT_LAS f32x4*)(wsf + 32 + 8 * g + 4 * hi);
#pragma unroll
        for (int i = 0; i < 4; ++i) { const int orow = 8 * g + 4 * hi + i;
            stg[orow * 64 + r32] = (bf16_t)f2bf(o[0][4 * g + i] * rl[i]); stg[orow * 64 + 32 + r32] = (bf16_t)f2bf(o[1][4 * g + i] * rl[i]); } }
#pragma unroll
    for (int i = 0; i < 4; ++i) { const int row = i * 8 + (lane >> 3), ch = lane & 7; const u32x4 v = *(const AT_LAS u32x4*)(stg + row * 64 + ch * 8); *(u32x4*)(Og + (size_t)row * rs + ch * 8) = v; }
}

constexpr int NRING = 4, LK = 0, LV = NRING * 8192, LW = 2 * NRING * 8192, LO = LW + 2048, LC = LO + 8 * 4096, ATT_LDS = LC + NRING * 1024;
__device__ __forceinline__ void qk64x(f32x16& p0, f32x16& p1, const AT_LAS char* kt, const bf16x8 (&qr)[4], const bf16x8 ax0, const bf16x8 ax1, const bf16x8 qx, int r32, int hi) {
    bf16x8 a[4], b[4]; const AT_LAS char* rp = kt + r32 * 128; const int x = r32 & 7;
#pragma unroll
    for (int d0 = 0; d0 < 4; ++d0) { const int so = ((2 * d0 + hi) ^ x) << 4; a[d0] = *(const AT_LAS bf16x8*)(rp + so); b[d0] = *(const AT_LAS bf16x8*)(rp + 4096 + so); }
    p0 = __builtin_amdgcn_mfma_f32_32x32x16_bf16(ax0, qx, (f32x16){}, 0, 0, 0); p1 = __builtin_amdgcn_mfma_f32_32x32x16_bf16(ax1, qx, (f32x16){}, 0, 0, 0);
#pragma unroll
    for (int d0 = 0; d0 < 4; ++d0) { p0 = __builtin_amdgcn_mfma_f32_32x32x16_bf16(a[d0], qr[d0], p0, 0, 0, 0); p1 = __builtin_amdgcn_mfma_f32_32x32x16_bf16(b[d0], qr[d0], p1, 0, 0, 0); }
}
__device__ __forceinline__ bf16x8 make_qx(float cm, int hi) {
    const unsigned hb = cvtpk(cm, 0.f) & 0xffffu; const float hf = __uint_as_float(hb << 16); const unsigned lb = cvtpk(cm - hf, 0.f) & 0xffffu;
    u32x4 w = (u32x4){hb | (lb << 16), 0x3F803F80u, 0u, 0u}; if (hi) w = (u32x4){0u, 0u, 0u, 0u};
    return __builtin_bit_cast(bf16x8, w);
}
constexpr float AT_THR = 4.0f;
template <int MODE> __device__ __forceinline__ void attn_block_unit(AT_LAS char* lds, const bf16_t* Qp, int ldq, const bf16_t* Kp, const bf16_t* Vp, int ldkv, int NT, int q0, const float* cl, const bf16_t* ckb, bf16_t* Op, int ldo, const int tid) {
    const int lane = tid & 63, r32 = lane & 31, hi = lane >> 5; const int wid = __builtin_amdgcn_readfirstlane(tid >> 6);
    AT_LAS float* wsf = (AT_LAS float*)(lds + LW) + wid * 64; AT_LAS bf16_t* stg = (AT_LAS bf16_t*)(lds + LO) + wid * 2048;
    const int qpos = q0 + wid * 32 + r32;
    const int lrow = wid * 8 + (lane >> 3), lslot = lane & 7;
    const bf16_t* ksrc = Kp + (size_t)lrow * ldkv + ((lslot ^ (lrow & 7)) << 3);
    const bf16_t* vsrc = Vp + (size_t)lrow * ldkv + ((lslot ^ ((lrow >> 1) & 7)) << 3);
    const bool xw = (MODE == 0) && (wid == 0);
#define AT_LOAD(t, bs) do { const int tt_ = NT - 1 - (t); const size_t to_ = (size_t)tt_ * 64 * ldkv; glds16(ksrc + to_, lds + LK + (bs) * 8192 + wid * 1024); glds16(vsrc + to_, lds + LV + (bs) * 8192 + wid * 1024); \
        if (xw) glds16(ckb + ((size_t)(tt_ * 64 + lane) << 3), lds + LC + (bs) * 1024); } while (0)
#define AT_WAITN(n) do { if (xw) { if ((n) >= 2) asm volatile("s_waitcnt vmcnt(6) lgkmcnt(0)" ::: "memory"); else if ((n) == 1) asm volatile("s_waitcnt vmcnt(3) lgkmcnt(0)" ::: "memory"); else asm volatile("s_waitcnt vmcnt(0) lgkmcnt(0)" ::: "memory"); } \
        else { if ((n) >= 2) asm volatile("s_waitcnt vmcnt(4) lgkmcnt(0)" ::: "memory"); else if ((n) == 1) asm volatile("s_waitcnt vmcnt(2) lgkmcnt(0)" ::: "memory"); else asm volatile("s_waitcnt vmcnt(0) lgkmcnt(0)" ::: "memory"); } } while (0)
    AT_LOAD(0, 0); if (NT > 1) AT_LOAD(1, 1); if (NT > 2) AT_LOAD(2, 2);
    bf16x8 qr[4];
#pragma unroll
    for (int d0 = 0; d0 < 4; ++d0) qr[d0] = *(const bf16x8*)(Qp + (size_t)qpos * ldq + d0 * 16 + hi * 8);
    float l = 0.f, cq = 0.f; if (MODE == 0) cq = cl[qpos];
    f32x16 o[2]; o[0] = f32x16{}; o[1] = f32x16{};
#pragma unroll
    for (int d0 = 0; d0 < 4; ++d0) asm volatile("" : "+v"(qr[d0]));
    asm volatile("" : "+v"(cq));
    float cm = cq;
    bf16x8 qx = make_qx(cm, hi);
    unsigned one2 = 0x3F803F80u, zz = 0u; asm volatile("" : "+v"(one2), "+v"(zz));
    const bf16x8 ax_const = __builtin_bit_cast(bf16x8, (u32x4){one2, zz, zz, zz});
    bool first = true;
#define AT_WAIT1(more) do { if (more) { if (xw) asm volatile("s_waitcnt vmcnt(3) lgkmcnt(0)" ::: "memory"); else asm volatile("s_waitcnt vmcnt(2) lgkmcnt(0)" ::: "memory"); } else asm volatile("s_waitcnt vmcnt(0) lgkmcnt(0)" ::: "memory"); } while (0)
#define AT_LIVE(t_) ((MODE == 1) || ((NT - 1 - (t_)) * 64 <= q0 + wid * 32 + 31))
#define AT_QK(t_, P) do { const int bq_ = (t_) & (NRING - 1), kq_ = (NT - 1 - (t_)) * 64; bf16x8 ax0_ = ax_const, ax1_ = ax_const; \
        if (MODE == 0) { ax0_ = *(const AT_LAS bf16x8*)(lds + LC + bq_ * 1024 + r32 * 16); ax1_ = *(const AT_LAS bf16x8*)(lds + LC + bq_ * 1024 + 512 + r32 * 16); } \
        qk64x(P[0], P[1], lds + LK + bq_ * 8192, qr, ax0_, ax1_, qx, r32, hi); \
        if (MODE == 0 && kq_ + 63 > q0 + wid * 32) {                                      \
            _Pragma("unroll") for (int b = 0; b < 2; ++b) _Pragma("unroll") for (int r = 0; r < 16; ++r) { const int key = kq_ + b * 32 + (r & 3) + 8 * (r >> 2) + 4 * hi; if (key > qpos) P[b][r] = -INFINITY; } } } while (0)
#define AT_STEP(t_, PC, PN) do { const int bs = (t_) & (NRING - 1); \
        if ((t_) + 3 < NT) AT_LOAD((t_) + 3, ((t_) + 3) & (NRING - 1));                   \
        const bool ln_ = ((t_) + 1 < NT) && AT_LIVE((t_) + 1); \
        if (ln_) AT_QK((t_) + 1, PN); \
        if (AT_LIVE(t_)) { \
            float mt = PC[0][0]; \
            _Pragma("unroll") for (int b = 0; b < 2; ++b) _Pragma("unroll") for (int r = 0; r < 16; ++r) mt = fmaxf(mt, PC[b][r]); \
            mt = swapmax(mt); \
            if (first || __any(mt > AT_THR)) {                                            \
                const float dl = first ? mt : fmaxf(mt, 0.f); \
                cm -= dl; qx = make_qx(cm, hi); \
                _Pragma("unroll") for (int b = 0; b < 2; ++b) _Pragma("unroll") for (int r = 0; r < 16; ++r) PC[b][r] -= dl; \
                if (ln_) { _Pragma("unroll") for (int b = 0; b < 2; ++b) _Pragma("unroll") for (int r = 0; r < 16; ++r) PN[b][r] -= dl; } \
                if (!first) { const float alpha = __builtin_amdgcn_exp2f(-dl); l *= alpha; \
                    if (hi == 0) wsf[r32] = alpha; \
                    _Pragma("unroll") for (int g = 0; g < 4; ++g) { const f32x4 a = *(const AT_LAS f32x4*)(wsf + 8 * g + 4 * hi); \
                        _Pragma("unroll") for (int i = 0; i < 4; ++i) { o[0][4 * g + i] *= a[i]; o[1][4 * g + i] *= a[i]; } } } \
                first = false; \
            } \
            float sm = 0.f; \
            _Pragma("unroll") for (int b = 0; b < 2; ++b) _Pragma("unroll") for (int r = 0; r < 16; ++r) { PC[b][r] = __builtin_amdgcn_exp2f(PC[b][r]); sm += PC[b][r]; } \
            l += sm; \
            pv64(o, PC[0], PC[1], lds + LV + bs * 8192, lane, hi); \
        } \
        AT_WAIT1((t_) + 3 < NT);                                                           \
        __builtin_amdgcn_s_barrier(); } while (0)
    AT_WAIT1(NT > 2);
    __builtin_amdgcn_s_barrier();
    f32x16 pa[2], pb[2];
    if (AT_LIVE(0)) AT_QK(0, pa);
    for (int t = 0; t < NT; t += 2) { AT_STEP(t, pa, pb); AT_STEP(t + 1, pb, pa); }
#undef AT_STEP
#undef AT_QK
#undef AT_LIVE
#undef AT_WAIT1
#undef AT_LOAD
#undef AT_WAITN
    attn_store(o, l, wsf, stg, Op + (size_t)(q0 + wid * 32) * ldo, (size_t)ldo, lane, r32, hi);
}

constexpr int DW_BYTES = 16384;
__device__ __forceinline__ void attn_dil_wave(AT_LAS char* lds0, AT_LAS char* wl, AT_LAS float* wsf, const bf16_t* QKV, bf16_t* MERGED, int b, int hh, int ib, int rho, int lane) {
    const int r32 = lane & 31, hi = lane >> 5, w8 = rho & 7, h8 = rho >> 3;
    float m = -1e30f, l = 0.f; f32x16 o[2]; o[0] = f32x16{}; o[1] = f32x16{};
    const size_t rowb = (size_t)b * SEQ;
    const unsigned vK = (unsigned)((lane >> 3) * 128 + (((lane & 7) ^ ((lane >> 3) & 7)) << 4)), vV0 = (unsigned)((lane >> 3) * 128 + (((lane & 7) ^ (lane >> 4)) << 4)), vV1 = (unsigned)((lane >> 3) * 128 + (((lane & 7) ^ ((lane >> 4) + 4)) << 4));
#define AT_DLOAD(KB, LO, tt, bs) do { AT_LAS char* bb_ = wl + (bs) * 8192; const char* kt_ = (const char*)(KB) + (size_t)((LO) + 32 * (tt)) * 128; \
            at::glds16x4(vK, kt_, bb_); at::glds16x2(vV0, kt_ + LA_K * 2, bb_ + 4096); at::glds16x2(vV1, kt_ + LA_K * 2 + 1024, bb_ + 4096 + 1024); } while (0)
#define AT_DTILES(QR, KB, LO, NTILE, LQ) do { \
        AT_DLOAD(KB, LO, 0, 0); \
        asm volatile("s_waitcnt vmcnt(0)" ::: "memory"); \
        for (int tt = 0; tt < (NTILE); ++tt) { \
            const int bs = tt & 1; \
            if (tt + 1 < (NTILE)) AT_DLOAD(KB, LO, tt + 1, bs ^ 1); \
            f32x16 p[1]; p[0] = qk32(wl + bs * 8192, QR, r32, hi); \
            const unsigned rel = (unsigned)((LO) + 32 * tt + 4 * hi - ((LQ) - 128));        \
            _Pragma("unroll") for (int r = 0; r < 16; ++r) { if (rel + (unsigned)((r & 3) + 8 * (r >> 2)) > 128u) p[0][r] = -INFINITY; } \
            softmax_step<1>(p, m, l, o, wsf, r32, hi); \
            pv32(o, p[0], wl + bs * 8192 + 4096, lane, hi); \
            asm volatile("s_waitcnt vmcnt(0) lgkmcnt(0)" ::: "memory"); \
        } } while (0)
    {
        const int j = r32 >> 3, r = r32 & 7, i0 = 4 * w8 + j, rho0 = 8 * h8 + r;
        const int lq = 16 * (32 * ib + i0) + rho0;
        const int tmin = 16 * (32 * ib + 4 * w8) + 8 * h8, lo = tmin > 128 ? tmin - 128 : 0, hiL = tmin + 55, ntile = ((hiL - lo) >> 5) + 1;
        const int gb = b * 4 + hh;
        const bf16_t* qrow = QKV + ((size_t)((gb * 16 + rho0) * 128 + 32 * ib + i0) << 6);
        const bf16_t* kbase = QKV + LA_K + ((size_t)(gb * SEQ) << 6);
        bf16x8 qr[4];
#pragma unroll
        for (int d0 = 0; d0 < 4; ++d0) qr[d0] = *(const bf16x8*)(qrow + d0 * 16 + hi * 8);
        AT_DTILES(qr, kbase, lo, ntile, lq);
        __syncthreads();
        AT_LAS float* X = (AT_LAS float*)lds0; AT_LAS float* ML = X + 8 * 32 * 64;
#pragma unroll
        for (int jj = 0; jj < 16; ++jj) { const int qh = (jj & 3) + 8 * (jj >> 2) + 4 * hi, dst = ((qh & 7) * 32 + 4 * w8 + (qh >> 3)) * 64 + r32;
            X[dst] = o[0][jj]; X[dst + 32] = o[1][jj]; }
        *(AT_LAS f32x2*)(ML + ((r * 32 + i0) * 2 + hi) * 2) = (f32x2){m, l};
        __syncthreads();
#pragma unroll
        for (int jj = 0; jj < 16; ++jj) { const int row = (jj & 3) + 8 * (jj >> 2) + 4 * hi, src = (w8 * 32 + row) * 64 + r32;
            o[0][jj] = X[src]; o[1][jj] = X[src + 32]; }
        { const f32x2 ml = *(const AT_LAS f32x2*)(ML + ((w8 * 32 + r32) * 2 + hi) * 2); m = ml.x; l = ml.y; }
        __syncthreads();
    }
    for (int g = 1; g < 3; ++g) {
        const int dsh = 2 * g, d = 1 << dsh, sigma = 16 >> dsh, rd = rho & (d - 1), rhod = rho >> dsh;
        const int lq = sigma * (32 * ib + r32) + rhod;
        const int lq0 = sigma * 32 * ib + rhod, lo = lq0 > 128 ? lq0 - 128 : 0, hiL = lq0 + 31 * sigma, ntile = ((hiL - lo) >> 5) + 1;
        const int gb = (g * 8 + b) * 4 + hh;
        const bf16_t* qbase = QKV + ((size_t)((gb * 16 + rho) * 128 + 32 * ib) << 6);
        const bf16_t* kbase = QKV + LA_K + ((size_t)(gb * SEQ + rd * (SEQ >> dsh)) << 6);
        bf16x8 qr[4];
#pragma unroll
        for (int d0 = 0; d0 < 4; ++d0) qr[d0] = *(const bf16x8*)(qbase + r32 * 64 + d0 * 16 + hi * 8);
        AT_DTILES(qr, kbase, lo, ntile, lq);
    }
#undef AT_DTILES
#undef AT_DLOAD
    attn_store(o, l, wsf, (AT_LAS bf16_t*)wl, MERGED + (rowb + 16 * 32 * ib + rho) * A_OUT + hh * 64, (size_t)16 * A_OUT, lane, r32, hi);
}
}

__device__ __forceinline__ void phase_attn_a(AT_LAS char* lds, const bf16_t* QKV, const bf16_t* MKV, bf16_t* MERGED, int G, int vcu, const int tid) {
    const int lane = tid & 63, wid = __builtin_amdgcn_readfirstlane(tid >> 6);
    for (int un = vcu; un < 256; un += G) {
        const int b = un >> 5, hh = (un >> 3) & 3, ib = (un >> 1) & 3, rho = (un & 1) * 8 + wid;
        at::attn_dil_wave(lds, lds + wid * at::DW_BYTES, (AT_LAS float*)(lds + 131072 + 8192 + wid * 256), QKV, MERGED, b, hh, ib, rho, lane);
    }
    __syncthreads();
    for (int un = vcu; un < 256; un += G) {
        const int b = un >> 5, h = (un >> 3) & 3, qb = un & 7;
        at::attn_block_unit<1>(lds, QKV + LA_QM + ((size_t)((b * 4 + h) * SEQ) << 6), 64, MKV + (size_t)b * MEM_LEN * 512 + h * 64, MKV + (size_t)b * MEM_LEN * 512 + 256 + h * 64, 512, 4, qb * 256, nullptr, nullptr,
                                 MERGED + (size_t)b * SEQ * A_OUT + 256 + h * 64, A_OUT, tid);
    }
}
__device__ __forceinline__ void fox_unit(AT_LAS char* lds, const bf16_t* QKV, const float* CUM, const bf16_t* CKB, bf16_t* MERGED, int bh, int qb, const int tid) {
    const int b = bh / NFOX, h = bh % NFOX;
    const size_t ho = (size_t)(bh * SEQ) << 6;
    at::attn_block_unit<0>(lds, QKV + LB_QF + ho, 64, QKV + ho, QKV + LB_V + ho, 64, 4 * (qb + 1), qb * 256,
                             CUM + (size_t)bh * SEQ, CKB + ((size_t)bh * SEQ << 3), MERGED + (size_t)b * SEQ * B_OUT + h * 64, B_OUT, tid);
}
__device__ __forceinline__ void phase_attn_b(AT_LAS char* lds, const bf16_t* QKV, const float* CUM, const bf16_t* CKB, const bf16_t* MKV, bf16_t* MERGED, int G, int vcu, const int tid) {
    if (G == 256) {
        const int grp = vcu >> 3, s = vcu & 7;
        const unsigned tq[8] = {0x704000u, 0x713010u, 0x722011u, 0x605001u, 0x614102u, 0x623121u, 0x514212u, 0x523222u};
        unsigned code = 0;
#pragma unroll
        for (int i = 0; i < 8; ++i) if (s == i) code = tq[i];
#pragma unroll 1
        for (int k = 0; k < 3; ++k) { const int qb = (code >> (20 - 8 * k)) & 15, pr = (code >> (16 - 8 * k)) & 15; fox_unit(lds, QKV, CUM, CKB, MERGED, grp * 3 + pr, qb, tid); }
    } else {
        for (int un = vcu; un < NB * NFOX * 8; un += G) { const int qb = 7 - un / (NB * NFOX), bh = un % (NB * NFOX); fox_unit(lds, QKV, CUM, CKB, MERGED, bh, qb, tid); }
    }
    for (int un = vcu; un < 256; un += G) {
        const int b = un >> 5, h = (un >> 3) & 3, qb = un & 7;
        at::attn_block_unit<1>(lds, QKV + LB_QM + ((size_t)((b * 4 + h) * SEQ) << 6), 64, MKV + (size_t)b * MEM_LEN * 512 + h * 64, MKV + (size_t)b * MEM_LEN * 512 + 256 + h * 64, 512, 4, qb * 256, nullptr, nullptr,
                                 MERGED + (size_t)b * SEQ * B_OUT + 768 + h * 64, B_OUT, tid);
    }
}
__device__ __forceinline__ void load_wT(float* wT, const float* W, int ldw, int coloff, int nw, int tid) {
    const int nch = nw >> 2;
    for (int i = tid; i < DM * nch; i += 512) { const int d = i & (DM - 1), k = i >> 10; const f32x4 w = *(const f32x4*)(W + (size_t)d * ldw + coloff + 4 * k);
        wT[(4 * k + 0) * DM + d] = w.x; wT[(4 * k + 1) * DM + d] = w.y; wT[(4 * k + 2) * DM + d] = w.z; wT[(4 * k + 3) * DM + d] = w.w; }
}
__device__ __forceinline__ void ln_rows(f32x4 (&v)[4], const float* g, const float* b, int lane) {
    float s = 0.f, q = 0.f;
#pragma unroll
    for (int j = 0; j < 4; ++j) { s += (v[j].x + v[j].y) + (v[j].z + v[j].w); q += (v[j].x * v[j].x + v[j].y * v[j].y) + (v[j].z * v[j].z + v[j].w * v[j].w); }
#pragma unroll
    for (int o = 1; o < 64; o <<= 1) { s += shx(s, o, lane); q += shx(q, o, lane); }
    const float mean = s * (1.f / DM), var = fmaxf(q * (1.f / DM) - mean * mean, 0.f);
    const float rstd = 1.0f / sqrtf(var + LN_EPS);
#pragma unroll
    for (int j = 0; j < 4; ++j) { const f32x4 gg = ((const f32x4*)g)[64 * j + lane], bb = ((const f32x4*)b)[64 * j + lane]; v[j] = (v[j] - mean) * rstd * gg + bb; }
}
__device__ __forceinline__ void ln_rows2(f32x4 (&v0)[4], f32x4 (&v1)[4], const float* g, const float* b, int lane) {
    float s0 = 0.f, q0 = 0.f, s1 = 0.f, q1 = 0.f;
#pragma unroll
    for (int j = 0; j < 4; ++j) { s0 += (v0[j].x + v0[j].y) + (v0[j].z + v0[j].w); q0 += (v0[j].x * v0[j].x + v0[j].y * v0[j].y) + (v0[j].z * v0[j].z + v0[j].w * v0[j].w);
                                  s1 += (v1[j].x + v1[j].y) + (v1[j].z + v1[j].w); q1 += (v1[j].x * v1[j].x + v1[j].y * v1[j].y) + (v1[j].z * v1[j].z + v1[j].w * v1[j].w); }
#pragma unroll
    for (int o = 1; o < 64; o <<= 1) { s0 += shx(s0, o, lane); q0 += shx(q0, o, lane); s1 += shx(s1, o, lane); q1 += shx(q1, o, lane); }
    const float m0 = s0 * (1.f / DM), m1 = s1 * (1.f / DM);
    const float r0 = 1.0f / sqrtf(fmaxf(q0 * (1.f / DM) - m0 * m0, 0.f) + LN_EPS), r1 = 1.0f / sqrtf(fmaxf(q1 * (1.f / DM) - m1 * m1, 0.f) + LN_EPS);
#pragma unroll
    for (int j = 0; j < 4; ++j) { const f32x4 gg = ((const f32x4*)g)[64 * j + lane], bb = ((const f32x4*)b)[64 * j + lane]; v0[j] = (v0[j] - m0) * r0 * gg + bb; v1[j] = (v1[j] - m1) * r1 * gg + bb; }
}
template <int N> __device__ __forceinline__ float reduce_lanes(float (&a)[N], int lane) {
    int n = N, mask = 32;
#pragma unroll
    for (; n > 1; n >>= 1, mask >>= 1) {
        const bool up = (lane & mask) != 0;
#pragma unroll
        for (int i = 0; i < n / 2; ++i) { float lo = a[i], hi = a[i + n / 2]; asm volatile("" : "+v"(lo), "+v"(hi));
            const float mine = up ? hi : lo, oth = up ? lo : hi; a[i] = mine + shx(oth, mask, lane); }
    }
    float r = a[0];
#pragma unroll
    for (; mask >= 1; mask >>= 1) r += shx(r, mask, lane);
    return r;
}
struct RowA { const float* PRE; const float* lng; const float* lnb; const float* wr; const float* br; float* X1; bf16_t* X1B; unsigned* cnt; int* rowtok; float* rowgate; int* tokpos; };
__device__ __forceinline__ void phase_row_a(AT_LAS unsigned char* ldsb, const RowA& P, int G, int bx, const int tid) {
    float* part = (float*)(unsigned char*)ldsb;
    int* s_e = (int*)((unsigned char*)ldsb + MISC_OFF + 512);
    float* s_g = (float*)(s_e + 256);
    int* s_rank = (int*)(s_g + 256);
    int* s_cnt = s_rank + 256;
    int* s_base = s_cnt + 32;
    const int lane = tid & 63, wave = tid >> 6;
    if (tid < 32) s_cnt[tid] = 0;
    __syncthreads();
    for (int blk = bx; blk < NTOK / 64; blk += G) {
        const int t0 = blk * 64;
        f32x4 n0[4], n1[4];
#pragma unroll
        for (int j = 0; j < 4; ++j) { n0[j] = ((const f32x4*)(P.PRE + (size_t)(t0 + wave * 8) * DM))[64 * j + lane]; n1[j] = ((const f32x4*)(P.PRE + (size_t)(t0 + wave * 8 + 1) * DM))[64 * j + lane]; }
#pragma unroll 1
        for (int i = 0; i < 8; i += 2) {
            const int row = t0 + wave * 8 + i;
            f32x4 v0[4], v1[4];
#pragma unroll
            for (int j = 0; j < 4; ++j) { v0[j] = n0[j]; v1[j] = n1[j]; }
            if (i + 2 < 8) {
#pragma unroll
                for (int j = 0; j < 4; ++j) { n0[j] = ((const f32x4*)(P.PRE + (size_t)(row + 2) * DM))[64 * j + lane]; n1[j] = ((const f32x4*)(P.PRE + (size_t)(row + 3) * DM))[64 * j + lane]; } }
            ln_rows2(v0, v1, P.lng, P.lnb, lane);
#pragma unroll
            for (int j = 0; j < 4; ++j) { ((f32x4*)(P.X1 + (size_t)row * DM))[64 * j + lane] = v0[j]; ((f32x4*)(P.X1 + (size_t)(row + 1) * DM))[64 * j + lane] = v1[j];
                ((u32x2*)(P.X1B + (size_t)row * DM))[64 * j + lane] = (u32x2){pk2(v0[j].x, v0[j].y), pk2(v0[j].z, v0[j].w)};
                ((u32x2*)(P.X1B + (size_t)(row + 1) * DM))[64 * j + lane] = (u32x2){pk2(v1[j].x, v1[j].y), pk2(v1[j].z, v1[j].w)}; }
        }
        asm volatile("s_waitcnt vmcnt(0)" ::: "memory");
        __syncthreads();
        {
            const int tb = wave >> 2, ks = wave & 3, ti = lane & 31, kh = lane >> 5;
            const float* xr = P.X1 + (size_t)(t0 + 32 * tb + ti) * DM + ks * 256 + 4 * kh;
            const float* wr = P.wr + (size_t)(ks * 256 + 4 * kh) * NEXP + ti;
            at::f32x16 acc = {};
#pragma unroll 4
            for (int c = 0; c < 32; ++c) {
                const f32x4 xa = __builtin_nontemporal_load((const f32x4*)(xr + 8 * c));
                const float w0 = wr[(8 * c + 0) * NEXP], w1 = wr[(8 * c + 1) * NEXP], w2 = wr[(8 * c + 2) * NEXP], w3 = wr[(8 * c + 3) * NEXP];
                acc = __builtin_amdgcn_mfma_f32_32x32x2f32(xa.x, w0, acc, 0, 0, 0); acc = __builtin_amdgcn_mfma_f32_32x32x2f32(xa.y, w1, acc, 0, 0, 0);
                acc = __builtin_amdgcn_mfma_f32_32x32x2f32(xa.z, w2, acc, 0, 0, 0); acc = __builtin_amdgcn_mfma_f32_32x32x2f32(xa.w, w3, acc, 0, 0, 0);
            }
            float* pw = part + wave * (32 * 33);
#pragma unroll
            for (int r = 0; r < 16; ++r) pw[((r & 3) + 8 * (r >> 2) + 4 * kh) * 33 + ti] = acc[r];
        }
        __syncthreads();
        if (tid < 64) {
            const float* p0 = part + ((tid >> 5) * 4) * (32 * 33) + (tid & 31) * 33;
            float lv[NEXP];
#pragma unroll
            for (int e = 0; e < NEXP; ++e) lv[e] = ((p0[e] + p0[32 * 33 + e]) + (p0[2 * 32 * 33 + e] + p0[3 * 32 * 33 + e])) + P.br[e];
            float tv[4]; int ti4[4];
#pragma unroll
            for (int k = 0; k < 4; ++k) { float bv = lv[0]; int bi = 0;
#pragma unroll
                for (int e = 1; e < NEXP; ++e) if (lv[e] > bv) { bv = lv[e]; bi = e; }
                tv[k] = bv; ti4[k] = bi;
#pragma unroll
                for (int e = 0; e < NEXP; ++e) if (e == bi) lv[e] = -INFINITY; }
            const float e1 = __builtin_amdgcn_exp2f(LOG2E * (tv[1] - tv[0])), e2 = __builtin_amdgcn_exp2f(LOG2E * (tv[2] - tv[0])), e3 = __builtin_amdgcn_exp2f(LOG2E * (tv[3] - tv[0])); const float inv = 1.0f / (1.0f + e1 + e2 + e3);
            const int r4 = tid * 4; s_e[r4 + 0] = ti4[0]; s_e[r4 + 1] = ti4[1]; s_e[r4 + 2] = ti4[2]; s_e[r4 + 3] = ti4[3];
            s_g[r4 + 0] = inv; s_g[r4 + 1] = e1 * inv; s_g[r4 + 2] = e2 * inv; s_g[r4 + 3] = e3 * inv;
        }
        __syncthreads();
        if (tid < 256) s_rank[tid] = atomicAdd(&s_cnt[s_e[tid]], 1);
        __syncthreads();
        if (tid < 32) { const int c = s_cnt[tid]; s_base[tid] = c ? (int)atomicAdd(&P.cnt[tid], (unsigned)c) : 0; }
        __syncthreads();
        if (tid < 256) { const int e = s_e[tid], idx = s_base[e] + s_rank[tid], tok = t0 + (tid >> 2);
            P.rowtok[(size_t)e * ECAP + idx] = tok; P.rowgate[(size_t)e * ECAP + idx] = s_g[tid]; P.tokpos[tok * 4 + (tid & 3)] = e * ECAP + idx; }
        if (tid < 32) s_cnt[tid] = 0;
        __syncthreads();
    }
}
struct RowB { const float* X1; const bf16_t* YROWS; const int* tokpos; const unsigned* cnt; const float* lng; const float* lnb; float* X2; bf16_t* X2B; const float* wsh; const float* bfg; float* FLOG; };
template <int MODE> __device__ __forceinline__ void phase_row_b(AT_LAS unsigned char* ldsb, const RowB& P, int G, int bx, const int tid) {
    float* wT = (float*)(unsigned char*)ldsb;
    int* s_pst = (int*)((unsigned char*)ldsb + MISC_OFF);
    const int lane = tid & 63, wave = tid >> 6;
    if (MODE == 0) load_wT(wT, P.wsh, 1548, 1536, NFOX, tid);
    if (tid == 0) { int acc = 0; for (int e = 0; e < NEXP; ++e) { s_pst[e] = acc * 256; acc += ((int)P.cnt[e] + 255) / 256; } }
    float mybias = 0.f; if (MODE == 0) { const int h = lane >> 2; if (h < NFOX) mybias = P.bfg[h]; }
    __syncthreads();
    for (int row = bx * 8 + wave; row < NTOK; row += G * 8) {
        f32x4 v[4];
        const int4 tp4 = *(const int4*)(P.tokpos + row * 4);
        const int tps[4] = {tp4.x, tp4.y, tp4.z, tp4.w};
        u32x2 w[4][4];
#pragma unroll
        for (int k = 0; k < 4; ++k) { const int tp = tps[k]; const int e = tp >> 14, idx = tp & (ECAP - 1); const size_t yr = (size_t)(s_pst[e] + idx);
#pragma unroll
            for (int j = 0; j < 4; ++j) w[k][j] = ((const u32x2*)(P.YROWS + yr * DM))[64 * j + lane]; }
#pragma unroll
        for (int j = 0; j < 4; ++j) v[j] = ((const f32x4*)(P.X1 + (size_t)row * DM))[64 * j + lane] * DN_ALPHA;
#pragma unroll
        for (int k = 0; k < 4; ++k)
#pragma unroll
            for (int j = 0; j < 4; ++j) { v[j].x += __uint_as_float(w[k][j].x << 16); v[j].y += __uint_as_float(w[k][j].x & 0xffff0000u); v[j].z += __uint_as_float(w[k][j].y << 16); v[j].w += __uint_as_float(w[k][j].y & 0xffff0000u); }
        ln_rows(v, P.lng, P.lnb, lane);
#pragma unroll
        for (int j = 0; j < 4; ++j) ((f32x4*)(P.X2 + (size_t)row * DM))[64 * j + lane] = v[j];
        if (MODE == 0) {
#pragma unroll
            for (int j = 0; j < 4; ++j) ((u32x2*)(P.X2B + (size_t)row * DM))[64 * j + lane] = (u32x2){pk2(v[j].x, v[j].y), pk2(v[j].z, v[j].w)};
            float a[16];
#pragma unroll
            for (int e = 0; e < 16; ++e) { float x = 0.f;
                if (e < NFOX) {
#pragma unroll
                    for (int j = 0; j < 4; ++j) { const f32x4 ww = ((const f32x4*)(wT + e * DM))[64 * j + lane]; x += (v[j].x * ww.x + v[j].y * ww.y) + (v[j].z * ww.z + v[j].w * ww.w); } }
                a[e] = x; }
            const float z = reduce_lanes<16>(a, lane) + mybias;
            if ((lane & 3) == 0 && (lane >> 2) < NFOX) { const float ls = fminf(z, 0.f) - 0.6931471805599453f * __builtin_amdgcn_logf(1.0f + __builtin_amdgcn_exp2f(-LOG2E * fabsf(z)));
                const int b = row >> 11, t = row & (SEQ - 1); P.FLOG[(size_t)(b * NFOX + (lane >> 2)) * SEQ + t] = ls; }
        }
    }
}
__device__ __forceinline__ void phase_cumsum(AT_LAS unsigned char* ldsb, const float* FLOG, float* CUM, bf16_t* CKB, int G, int bx, const int tid) {
    float* wsum = (float*)((unsigned char*)ldsb + MISC_OFF + 4096);
    const int lane = tid & 63, wave = tid >> 6;
    for (int q = bx; q < NB * NFOX; q += G) {
        const size_t base = (size_t)q * SEQ;
        const f32x4 x = ((const f32x4*)(FLOG + base))[tid];
        const float a0 = x.x, a1 = a0 + x.y, a2 = a1 + x.z, a3 = a2 + x.w;
        float incl = a3;
#pragma unroll
        for (int o = 1; o < 64; o <<= 1) { const float y = __int_as_float(__builtin_amdgcn_ds_bpermute(((lane - o) & 63) << 2, __float_as_int(incl))); if (lane >= o) incl += y; }
        if (lane == 63) wsum[wave] = incl;
        __syncthreads();
        float off = 0.f; for (int w = 0; w < wave; ++w) off += wsum[w];
        const float ex = off + incl - a3;
        const f32x4 cv = (f32x4){(ex + a0) * LOG2E, (ex + a1) * LOG2E, (ex + a2) * LOG2E, (ex + a3) * LOG2E};
        ((f32x4*)(CUM + base))[tid] = cv;
#pragma unroll
        for (int i = 0; i < 4; ++i) { const float nc = -cv[i]; const unsigned hb = pk2(nc, 0.f) & 0xffffu; const float hf = __uint_as_float(hb << 16); const unsigned lb = pk2(nc - hf, 0.f) & 0xffffu;
            ((u32x4*)(CKB + (base + (size_t)tid * 4 + i) * 8))[0] = (u32x4){0x3F803F80u, hb | (lb << 16), 0u, 0u}; }
        __syncthreads();
    }
}

#define XB_TMO      128
#define XB_XCNT(j)  (256  + 64 * (j))
#define XB_XSUB(j)  (1280 + 64 * (j))
#define XB_XGEN(j)  (2304 + 64 * (j))
#define XB_TOP      3328
#define XB_TOPGEN   3392
#define XCD_BAR_WORDS 3456
#define XB_SPIN_CAP (1u << 18)
__device__ __forceinline__ unsigned xb_ld(unsigned* p)              { return __hip_atomic_load(p, __ATOMIC_RELAXED, __HIP_MEMORY_SCOPE_AGENT); }
__device__ __forceinline__ unsigned xb_add(unsigned* p, unsigned v) { return __hip_atomic_fetch_add(p, v, __ATOMIC_RELAXED, __HIP_MEMORY_SCOPE_AGENT); }
__device__ __forceinline__ unsigned xb_xcc_id() { return (unsigned)__builtin_amdgcn_s_getreg((3 << 11) | 20) & 0xFu; }
#define XB_SPIN(cond, bar) do { unsigned _sp = 0; while (cond) { __builtin_amdgcn_s_sleep(1); \
    if ((++_sp & 255u) == 0u) { if (xb_ld(&(bar)[XB_TMO])) break; if (_sp > XB_SPIN_CAP) { atomicAdd(&(bar)[XB_TMO], 1u); break; } } } } while (0)
struct XcdBarrier { unsigned* bar; unsigned x; volatile AT_LAS unsigned* st; };
__device__ __forceinline__ XcdBarrier xcd_barrier_post(unsigned* bar, volatile AT_LAS unsigned* st, int tid) {
    XcdBarrier b; b.bar = bar; b.x = xb_xcc_id(); b.st = st;
    if (tid == 0) (void)xb_add(&bar[XB_XCNT(b.x)], 1u);
    return b;
}
__device__ __forceinline__ void xcd_barrier_complete(unsigned* bar, unsigned x, unsigned& nloc, unsigned& nx) {
    const unsigned G = gridDim.x * gridDim.y * gridDim.z;
    unsigned sum, cnt, mine, sp = 0u;
    for (;;) {
        sum = 0u; cnt = 0u; mine = 0u;
#pragma unroll
        for (unsigned j = 0; j < 16; ++j) { const unsigned c = xb_ld(&bar[XB_XCNT(j)]); sum += c; cnt += (c > 0u) ? 1u : 0u; mine = (j == x) ? c : mine; }
        if (sum == G) break;
        __builtin_amdgcn_s_sleep(1);
        if ((++sp & 255u) == 0u) { if (xb_ld(&bar[XB_TMO])) break; if (sp > XB_SPIN_CAP) { atomicAdd(&bar[XB_TMO], 1u); break; } }
    }
    nloc = mine > 0u ? mine : 1u; nx = cnt > 0u ? cnt : 1u;
}
__device__ __forceinline__ void xcd_barrier(const XcdBarrier& b, int tid) {
    asm volatile("s_waitcnt vmcnt(0)" ::: "memory");
    __syncthreads();
    if (tid == 0) {
        unsigned* bar = b.bar; asm volatile("" : "+s"(bar));
        __builtin_amdgcn_s_waitcnt(0);
        unsigned nloc = b.st[0], nx = b.st[1];
        if (nloc == 0u) { xcd_barrier_complete(bar, b.x, nloc, nx); b.st[0] = nloc; b.st[1] = nx; }
        const unsigned old = xb_add(&bar[XB_XSUB(b.x)], 1u);
        const unsigned gen = old / nloc;
        if (old + 1u == (gen + 1u) * nloc) {
            __builtin_amdgcn_fence(__ATOMIC_RELEASE, "agent");
            asm volatile("s_waitcnt vmcnt(0)" ::: "memory");
            const unsigned og = xb_add(&bar[XB_TOP], 1u);
            const unsigned tg = og / nx;
            if (og + 1u == (tg + 1u) * nx) xb_add(&bar[XB_TOPGEN], 1u);
            else XB_SPIN(xb_ld(&bar[XB_TOPGEN]) == tg, bar);
            __builtin_amdgcn_fence(__ATOMIC_ACQUIRE, "agent");
            xb_add(&bar[XB_XGEN(b.x)], 1u);
            asm volatile("s_waitcnt vmcnt(0)" ::: "memory");
        } else {
            XB_SPIN(xb_ld(&bar[XB_XGEN(b.x)]) == gen, bar);
            __builtin_amdgcn_fence(__ATOMIC_ACQUIRE, "agent");
            asm volatile("s_waitcnt vmcnt(0)" ::: "memory");
        }
    }
    __syncthreads();
}

struct TrJob { const float* W; int ldw, K, Np; bf16_t* WT; int nmat; size_t sstride, dstride; };
template <int MAP> __device__ __forceinline__ void tr_job(const TrJob& j, float* scr, int gw, int NGW, int lane) {
    const int nblk = j.Np / 32, per = (j.K / 64) * nblk; const long total = (long)per * j.nmat;
    for (long it = gw; it < total; it += NGW) { const int mat = (int)(it / per), item = (int)(it % per);
        transpose_item<MAP>(j.W + mat * j.sstride, j.ldw, 0, j.K, j.WT + mat * j.dstride, item, nblk, scr, lane); }
}
__device__ __forceinline__ void cvt_rows(const float* src, bf16_t* dst, size_t n8, size_t gt, size_t NGT) {
    for (size_t i = gt; i < n8; i += NGT) { const f32x4 a = ((const f32x4*)src)[2 * i], b = ((const f32x4*)src)[2 * i + 1];
        u32x4 o; o.x = pk2(a.x, a.y); o.y = pk2(a.z, a.w); o.z = pk2(b.x, b.y); o.w = pk2(b.z, b.w); ((u32x4*)dst)[i] = o; }
}

constexpr unsigned STEAL_D0 = 32u * 512u, STEAL_GU = STEAL_D0 + 32u * 1024u, STEAL_TOTAL = STEAL_GU + 32u * 512u;
constexpr int CW_QNEXT = 512, CW_DONE = 576;
__device__ __forceinline__ void steal_convert(AT_LAS unsigned char* lds, unsigned char* lds_gen, const float* w_gu, const float* w_dn, bf16_t* WT_GU, bf16_t* WT_DN, unsigned* qnext, unsigned* done, unsigned limit, int G, int tid) {
    const int lane = tid & 63, wave = __builtin_amdgcn_readfirstlane(tid >> 6);
    float* scr = (float*)lds_gen + wave * 64 * 33;
    volatile AT_LAS unsigned* slot = (volatile AT_LAS unsigned*)(lds + MISC_OFF + 384);
    __syncthreads();
    if (done && tid == 0) __hip_atomic_fetch_add(done, 1u, __ATOMIC_RELAXED, __HIP_MEMORY_SCOPE_AGENT);
    for (;;) {
        if (tid == 0) { unsigned it = 0xFFFFFFFFu;
            const bool alldone = !done || __hip_atomic_load(done, __ATOMIC_RELAXED, __HIP_MEMORY_SCOPE_AGENT) >= (unsigned)G;
            const bool stop = alldone && __hip_atomic_load(qnext, __ATOMIC_RELAXED, __HIP_MEMORY_SCOPE_AGENT) >= limit;
            if (!stop) it = __hip_atomic_fetch_add(qnext, 8u, __ATOMIC_RELAXED, __HIP_MEMORY_SCOPE_AGENT);
            *slot = it; }
        __syncthreads();
        const unsigned it0 = *slot;
        __syncthreads();
        if (it0 >= STEAL_TOTAL) break;
        const unsigned it = it0 + (unsigned)wave;
        if (it < STEAL_D0) { const int mat = (int)(it >> 9), item = (int)(it & 511);
            transpose_item<0>(w_dn + (size_t)mat * DFF * DM, DM, 0, DFF, WT_DN + (size_t)mat * DM * DFF, item, 32, scr, lane); }
        else if (it < STEAL_GU) { const unsigned r = it - STEAL_D0; const int mat = (int)(r >> 10), item = (int)(r & 1023);
            transpose_item<2>(w_gu + (size_t)(32 + mat) * DM * 2048, 2048, 0, DM, WT_GU + (size_t)(32 + mat) * 2048 * DM, item, 64, scr, lane); }
        else if (it < STEAL_TOTAL) { const unsigned r = it - STEAL_GU; const int mat = (int)(r >> 9), item = (int)(r & 511);
            transpose_item<0>(w_dn + (size_t)(32 + mat) * DFF * DM, DM, 0, DFF, WT_DN + (size_t)(32 + mat) * DM * DFF, item, 32, scr, lane); }
    }
}

constexpr int CW_BAR = 4096;
constexpr int NPHASE = 15;
#ifndef PROBE_MASK
#define PROBE_MASK 0
#endif
struct MegaArgs { const float* in[19]; float* out; unsigned char* ws; int ph_lo, ph_hi; };
__device__ __forceinline__ int lane_id_volatile() { int l; asm volatile("v_mbcnt_lo_u32_b32 %0, -1, 0\n\tv_mbcnt_hi_u32_b32 %0, -1, %0" : "=v"(l)); return l; }
#define OPQ_S(x) asm volatile("" : "+s"(x))
#define OPQ_V(x) asm volatile("" : "+v"(x))
__global__ void __launch_bounds__(512, 2) k_mega(MegaArgs a) {
    extern __shared__ __attribute__((aligned(16))) unsigned char lds_raw[];
    AT_LAS unsigned char* lds = (AT_LAS unsigned char*)lds_raw;
    { const int t0 = threadIdx.x; for (int u = t0; u < (FAST_LDS - MISC_OFF) / 4; u += 512) ((AT_LAS unsigned*)(lds + MISC_OFF))[u] = 0u; }
    __syncthreads();
    const int lo = a.ph_lo, hi = a.ph_hi;
    const int wave_s = __builtin_amdgcn_readfirstlane(threadIdx.x >> 6);
    XcdBarrier bar; bar.bar = (unsigned*)(a.ws + WS_CTL) + CW_BAR; bar.x = 0; bar.st = (volatile AT_LAS unsigned*)(lds + MISC_OFF + 256);
    if (hi - lo > 1) bar = xcd_barrier_post((unsigned*)(a.ws + WS_CTL) + CW_BAR, (volatile AT_LAS unsigned*)(lds + MISC_OFF + 256), threadIdx.x);
#define PH_ENTER \
        int tid = wave_s * 64 + lane_id_volatile(); OPQ_V(tid); const __attribute__((address_space(4))) MegaArgs* ap = (const __attribute__((address_space(4))) MegaArgs*)__builtin_amdgcn_kernarg_segment_ptr(); OPQ_S(ap); unsigned char* ws = ap->ws; int G = gridDim.x, bx = blockIdx.x; OPQ_S(G); OPQ_S(bx); const int vcu = vcu_of(bx, G); (void)vcu; \
        const int l = (ph >= 8) ? 1 : 0; unsigned* cnt = (unsigned*)(ws + WS_CTL) + CW_CNT + l * 64; (void)cnt; AT_LAS int* pre = (AT_LAS int*)(lds + MISC_OFF); (void)pre;
#define P_BF(off) ((bf16_t*)(ws + (off)))
#define P_F32(off) ((float*)(ws + (off)))
#define STEAL(k, lim) steal_convert(lds, lds_raw, ap->in[15], ap->in[17], P_BF(WS_WT_GU), P_BF(WS_WT_DN), (unsigned*)(ws + WS_CTL) + CW_QNEXT, (k) < 0 ? nullptr : (unsigned*)(ws + WS_CTL) + CW_DONE + 64 * (k), (lim), G, tid)
#pragma unroll 1
    for (int r0 = 0; r0 < ((lo == 0) ? 1 + (PROBE_MASK & 1) : 0); ++r0) { const int ph = 0; PH_ENTER
            const int lane = tid & 63, wave = __builtin_amdgcn_readfirstlane(tid >> 6);
            float* scr = (float*)lds_raw + wave * 64 * 33;
            const int gw = vcu * 8 + wave, NGW = G * 8;
#define GW_AT(off) ((gw + NGW - ((off) % NGW)) % NGW)
            tr_job<1>(TrJob{ap->in[2], A_IN, DM, A_IN, P_BF(WS_WT_INA), 1, 0, 0}, scr, GW_AT(0), NGW, lane);
            tr_job<0>(TrJob{ap->in[6], 1548, DM, 1536, P_BF(WS_WT_INB), 1, 0, 0}, scr, GW_AT(1280), NGW, lane);
            tr_job<0>(TrJob{ap->in[4], 1024, DM, 1024, P_BF(WS_WT_INB) + (size_t)1536 * DM, 1, 0, 0}, scr, GW_AT(2048), NGW, lane);
            tr_job<0>(TrJob{ap->in[3], DM, A_OUT, DM, P_BF(WS_WT_OUTA), 1, 0, 0}, scr, GW_AT(2560), NGW, lane);
            tr_job<0>(TrJob{ap->in[5], DM, B_OUT, DM, P_BF(WS_WT_OUTB), 1, 0, 0}, scr, GW_AT(2816), NGW, lane);
            tr_job<0>(TrJob{ap->in[8], 512, DM, 512, P_BF(WS_WT_MKV), 2, (size_t)DM * 512, (size_t)512 * DM}, scr, GW_AT(3328), NGW, lane);
            tr_job<2>(TrJob{ap->in[15], 2048, DM, 2048, P_BF(WS_WT_GU), 32, (size_t)DM * 2048, (size_t)2048 * DM}, scr, GW_AT(3840), NGW, lane);
#undef GW_AT
            const size_t gt = (size_t)vcu * 512 + tid, NGT = (size_t)G * 512;
            cvt_rows(ap->in[0], P_BF(WS_XB), (size_t)NTOK * DM / 8, gt, NGT);
            cvt_rows(ap->in[1], P_BF(WS_MEMB), (size_t)NMEMROW * DM / 8, gt, NGT);
        if (hi > 1) xcd_barrier(bar, tid);
    }
#pragma unroll 1
    for (int pp = 2 * (lo < 1 ? 1 : lo); pp < 2 * hi; ++pp) {
        const int ph = pp >> 1;
        if ((pp & 1) && !((PROBE_MASK >> ph) & 1)) continue;
        switch (ph) {
        case 1: { PH_ENTER
            const bf16_t* WT_MKV = P_BF(WS_WT_MKV); const bf16_t* MEMB = P_BF(WS_MEMB); bf16_t* MEMKV = P_BF(WS_MEMKV);
            { fg::DenseSched S; S.init(P_BF(WS_WT_INA), NTOK, A_IN, DM, G, bx); fg::gemm_phase<0>(lds, P_BF(WS_XB), DM, S, EpiInA{P_BF(WS_QKV)}, tid); }
            { fg::DenseSched S; S.init(WT_MKV, NMEMROW, 512, DM, G, (bx + G / 2) % G); fg::gemm_phase<0>(lds, MEMB, DM, S, EpiPlain{MEMKV, 512, 0}, tid); }
            { fg::DenseSched S; S.init(WT_MKV + (size_t)512 * DM, NMEMROW, 512, DM, G, (bx + G / 2 + G - 16) % G); fg::gemm_phase<0>(lds, MEMB, DM, S, EpiPlain{MEMKV + (size_t)NMEMROW * 512, 512, 0}, tid); }
            STEAL(0, 0u);
        } break;
        case 2: { PH_ENTER phase_attn_a((AT_LAS char*)lds, P_BF(WS_QKV), P_BF(WS_MEMKV), P_BF(WS_MERGED), G, vcu, tid); } break;
        case 3: { PH_ENTER fg::DenseSched S; S.init(P_BF(WS_WT_OUTA), NTOK, DM, A_OUT, G, bx); fg::gemm_phase<0>(lds, P_BF(WS_MERGED), A_OUT, S, EpiOut{P_F32(WS_PRE), ap->in[0]}, tid); } break;
        case 4: case 11: { PH_ENTER
            if (l == 1) STEAL(-1, STEAL_GU);
            phase_row_a(lds, RowA{P_F32(WS_PRE), ap->in[9] + l * DM, ap->in[10] + l * DM, ap->in[13] + (size_t)l * DM * NEXP, ap->in[14] + l * NEXP, P_F32(WS_X1), P_BF(WS_X1B), cnt,
                                  (int*)(ws + WS_ROWTOK), P_F32(WS_ROWGATE), (int*)(ws + WS_TOKPOS)}, G, bx, tid); } break;
        case 5: case 12: { PH_ENTER fg::moe_prefix(cnt, pre, 8, tid); fg::MoeSched<1> S{P_BF(WS_WT_GU) + (size_t)l * 32 * 2048 * DM, cnt, (const int*)(ws + WS_ROWTOK), pre, G, vcu};
            fg::gemm_phase<1>(lds, P_BF(WS_X1B), DM, S, EpiGU{P_BF(WS_ACT), ap->in[16] + (size_t)l * 32 * 2048}, tid);
            if (l == 0) STEAL(1, STEAL_D0); else STEAL(4, STEAL_TOTAL); } break;
        case 6: case 13: { PH_ENTER fg::moe_prefix(cnt, pre, 4, tid); fg::MoeSched<0> S{P_BF(WS_WT_DN) + (size_t)l * 32 * DM * DFF, cnt, nullptr, pre, G, vcu};
            fg::gemm_phase<0>(lds, P_BF(WS_ACT), DFF, S, EpiDN{P_BF(WS_YROWS), ap->in[18] + (size_t)l * 32 * DM, P_F32(WS_ROWGATE)}, tid); if (l == 0) STEAL(2, 0u); } break;
        case 7: { PH_ENTER phase_row_b<0>(lds, RowB{P_F32(WS_X1), P_BF(WS_YROWS), (const int*)(ws + WS_TOKPOS), cnt, ap->in[11], ap->in[12], P_F32(WS_X2), P_BF(WS_XB), ap->in[6], ap->in[7], P_F32(WS_FLOG)}, G, bx, tid); } break;
        case 8: { PH_ENTER phase_cumsum(lds, P_F32(WS_FLOG), P_F32(WS_CUM), P_BF(WS_CKB), G, bx, tid);
            fg::DenseSched S; S.init(P_BF(WS_WT_INB), NTOK, B_IN, DM, G, bx); fg::gemm_phase<0>(lds, P_BF(WS_XB), DM, S, EpiInB{P_BF(WS_QKV)}, tid); STEAL(3, 0u); } break;
        case 9: { PH_ENTER phase_attn_b((AT_LAS char*)lds, P_BF(WS_QKV), P_F32(WS_CUM), P_BF(WS_CKB), P_BF(WS_MEMKV) + (size_t)NMEMROW * 512, P_BF(WS_MERGED), G, vcu, tid); } break;
        case 10: { PH_ENTER fg::DenseSched S; S.init(P_BF(WS_WT_OUTB), NTOK, DM, B_OUT, G, bx); fg::gemm_phase<0>(lds, P_BF(WS_MERGED), B_OUT, S, EpiOut{P_F32(WS_PRE), P_F32(WS_X2)}, tid); } break;
        case 14: { PH_ENTER phase_row_b<1>(lds, RowB{P_F32(WS_X1), P_BF(WS_YROWS), (const int*)(ws + WS_TOKPOS), cnt, ap->in[11] + DM, ap->in[12] + DM, ap->out, nullptr, nullptr, nullptr, nullptr}, G, bx, tid); } break;
        default: break;
        }
#undef PH_ENTER
        if (pp + 1 < 2 * hi) { int tb = wave_s * 64 + lane_id_volatile(); OPQ_V(tb); xcd_barrier(bar, tb);
#if defined(PROBE_BAR)
            xcd_barrier(bar, tb);
#endif
        }
    }
}

#ifndef N_LAUNCHES
#define N_LAUNCHES 1
#endif
extern "C" void kernel_launch(void* const* d_in, const int* in_sizes, int n_in, void* d_out, int out_size, void* d_ws, size_t ws_size, hipStream_t stream) {
    static int grid = 0;
    if (grid == 0) {
        if (n_in != 19 || out_size != NTOK * DM || ws_size < WS_END) { fprintf(stderr, "kernel_launch: unexpected shapes (n_in %d out %d ws %zu)\n", n_in, out_size, ws_size); grid = -1; return; }
        int dev = 0, cus = 0;
        if (hipGetDevice(&dev) != hipSuccess || hipDeviceGetAttribute(&cus, hipDeviceAttributeMultiprocessorCount, dev) != hipSuccess || cus <= 0) { fprintf(stderr, "kernel_launch: device query failed\n"); grid = -1; return; }
        if (hipFuncSetAttribute((const void*)k_mega, hipFuncAttributeMaxDynamicSharedMemorySize, FAST_LDS) != hipSuccess) { fprintf(stderr, "kernel_launch: hipFuncSetAttribute failed\n"); grid = -1; return; }
        grid = cus;
    }
    if (grid < 0) return;
    (void)hipMemsetAsync((char*)d_ws + WS_CTL, 0, 1 * MiB, stream);
    MegaArgs a{};
    for (int i = 0; i < 19; ++i) a.in[i] = (const float*)d_in[i];
    a.out = (float*)d_out; a.ws = (unsigned char*)d_ws;
    if (N_LAUNCHES == 1) { a.ph_lo = 0; a.ph_hi = NPHASE; hipLaunchKernelGGL(k_mega, dim3(grid), dim3(512), FAST_LDS, stream, a); }
    else for (int p = 0; p < NPHASE; ++p) { a.ph_lo = p; a.ph_hi = p + 1; hipLaunchKernelGGL(k_mega, dim3(grid), dim3(512), FAST_LDS, stream, a); }
}
```

```cpp
#include <hip/hip_runtime.h>
#include <cstdio>
#include <cstdint>

typedef unsigned short bf16_t;
typedef float f32x4 __attribute__((ext_vector_type(4)));
typedef float f32x2 __attribute__((ext_vector_type(2)));
typedef unsigned u32x4 __attribute__((ext_vector_type(4)));
typedef unsigned u32x2 __attribute__((ext_vector_type(2)));

constexpr int DM = 1024, NB = 8, SEQ = 2048, NTOK = NB * SEQ, HD = 64;
constexpr int MEM_LEN = 256, NMEMROW = NB * MEM_LEN;
constexpr int A_IN = 2560, A_OUT = 512, B_IN = 2560  , B_OUT = 1024;
constexpr int NEXP = 32, TOPK = 4, DFF = 1024, ECAP = NTOK;
constexpr int NFOX = 12;
constexpr int MAXROWS = 73728;
constexpr size_t LA_K = (size_t)3 * 8 * 4 * 2048 * 64, LA_QM = 3 * LA_K;
constexpr size_t LB_V = (size_t)768 * 16384, LB_QF = 2 * LB_V, LB_QM = 3 * LB_V;
constexpr float LN_EPS = 1e-5f;
constexpr float DN_ALPHA = 1.4142135623730951f;
constexpr float C2 = 0.125f * 1.4426950408889634f;
constexpr float LOG2E = 1.4426950408889634f;
constexpr float SW_LIMIT = 7.0f, SW_ALPHA = 1.702f;

constexpr size_t MiB = 1ull << 20;
constexpr size_t WS_CTL = 0;
constexpr size_t WS_ROPE = 1 * MiB;
constexpr size_t WS_CUM = 2 * MiB;
constexpr size_t WS_FLOG = 3 * MiB;
constexpr size_t WS_ROWTOK = 4 * MiB;
constexpr size_t WS_ROWGATE = 6 * MiB;
constexpr size_t WS_TOKPOS = 8 * MiB;
constexpr size_t WS_MEMB = 10 * MiB;
constexpr size_t WS_MEMKV = 14 * MiB;
constexpr size_t WS_WT_INA = 18 * MiB;
constexpr size_t WS_WT_INB = 23 * MiB;
constexpr size_t WS_WT_OUTA = 28 * MiB;
constexpr size_t WS_WT_OUTB = 29 * MiB;
constexpr size_t WS_WT_MKV = 31 * MiB;
constexpr size_t WS_XB = 34 * MiB;
constexpr size_t WS_X1B = 66 * MiB;
constexpr size_t WS_QKV = 98 * MiB;
constexpr size_t WS_MERGED = 178 * MiB;
constexpr size_t WS_PRE = 210 * MiB;
constexpr size_t WS_X1 = 274 * MiB;
constexpr size_t WS_X2 = 338 * MiB;
constexpr size_t WS_ACT = 402 * MiB;
constexpr size_t WS_YROWS = 546 * MiB;
constexpr size_t WS_WT_GU = 690 * MiB;
constexpr size_t WS_WT_DN = 946 * MiB;
constexpr size_t WS_CKB = 1074 * MiB;
constexpr size_t WS_END = 1078 * MiB;
constexpr int CW_CNT = 64;

__device__ __forceinline__ float bf2f(bf16_t v) { return __uint_as_float((unsigned)v << 16); }
__device__ __forceinline__ unsigned f2bf(float f) { unsigned u = __float_as_uint(f); return (u + 0x7fffu + ((u >> 16) & 1u)) >> 16; }
typedef __bf16 hwbf16x2_t __attribute__((ext_vector_type(2)));
__device__ __forceinline__ unsigned pk2(float lo, float hi) { f32x2 v = {lo, hi}; hwbf16x2_t b = __builtin_convertvector(v, hwbf16x2_t); return __builtin_bit_cast(unsigned, b); }
__device__ __forceinline__ void unpack8(const u32x4 w, float* f) {
    f[0] = __uint_as_float(w.x << 16); f[1] = __uint_as_float(w.x & 0xffff0000u);
    f[2] = __uint_as_float(w.y << 16); f[3] = __uint_as_float(w.y & 0xffff0000u);
    f[4] = __uint_as_float(w.z << 16); f[5] = __uint_as_float(w.z & 0xffff0000u);
    f[6] = __uint_as_float(w.w << 16); f[7] = __uint_as_float(w.w & 0xffff0000u);
}
__device__ __forceinline__ float shx(float v, int mask, int lane) { return __int_as_float(__builtin_amdgcn_ds_bpermute((lane ^ mask) << 2, __float_as_int(v))); }

__constant__ double c_invfreq[32] = {1.0, 0.7498942093324559, 0.5623413251903491, 0.4216965034285822, 0.31622776601683794, 0.23713737056616552, 0.1778279410038923, 0.1333521432163324, 0.1, 0.07498942093324558, 0.05623413251903491, 0.042169650342858224, 0.03162277660168379, 0.023713737056616554, 0.01778279410038923, 0.01333521432163324, 0.01, 0.007498942093324558, 0.005623413251903491, 0.004216965034285823, 0.0031622776601683794, 0.0023713737056616554, 0.0017782794100389228, 0.001333521432163324, 0.001, 0.0007498942093324559, 0.0005623413251903491, 0.00042169650342858224, 0.00031622776601683794, 0.00023713737056616554, 0.00017782794100389227, 0.0001333521432163324};

__device__ __forceinline__ void sincos_d(double a, float& s, float& c) {
    const double n = rint(a * 0.15915494309189535);
    double r = fma(-n, 6.283185307179586, a);
    r = fma(-n, 2.4492935982947064e-16, r);
    const double h = 0.5 * r, h2 = h * h;
    double sp = 1.0 / 355687428096000.0;
    sp = fma(sp, h2, -1.0 / 1307674368000.0); sp = fma(sp, h2, 1.0 / 6227020800.0); sp = fma(sp, h2, -1.0 / 39916800.0);
    sp = fma(sp, h2, 1.0 / 362880.0); sp = fma(sp, h2, -1.0 / 5040.0); sp = fma(sp, h2, 1.0 / 120.0); sp = fma(sp, h2, -1.0 / 6.0); sp = fma(sp, h2, 1.0);
    const double sh = sp * h;
    double cp = 1.0 / 20922789888000.0;
    cp = fma(cp, h2, -1.0 / 87178291200.0); cp = fma(cp, h2, 1.0 / 479001600.0); cp = fma(cp, h2, -1.0 / 3628800.0);
    cp = fma(cp, h2, 1.0 / 40320.0); cp = fma(cp, h2, -1.0 / 720.0); cp = fma(cp, h2, 1.0 / 24.0); cp = fma(cp, h2, -0.5); cp = fma(cp, h2, 1.0);
    s = (float)(2.0 * sh * cp); c = (float)(1.0 - 2.0 * sh * sh);
}

template <int MAP> __device__ __forceinline__ int colmap(int p) {
    if (MAP == 1) {
        if (p >= 2304) return p;
        const int rem = p % 768, part = rem >> 8;
        if (part == 2) return p;
        const int dd = p & 63, d = (dd & 1) ? (dd >> 1) + 32 : (dd >> 1);
        return (p & ~63) + d;
    } else if (MAP == 2) {
        return ((p & 255) >> 7) * 1024 + (p >> 8) * 128 + (p & 127);
    }
    return p;
}
template <int MAP> __device__ __forceinline__ void transpose_item(const float* __restrict__ W, int ldw, int coloff, int K, bf16_t* __restrict__ WT, int item, int nblk, float* scr, int lane) {
    const int kb = item / nblk, nb = item % nblk, k0 = 64 * kb, n0 = 32 * nb;
    if (MAP == 1) {
        const int srcc = coloff + colmap<MAP>(n0 + (lane & 31));
#pragma unroll 8
        for (int i = 0; i < 32; ++i) { const int kk = 2 * i + (lane >> 5); scr[kk * 33 + (lane & 31)] = W[(size_t)(k0 + kk) * ldw + srcc]; }
    } else {
        const int c4 = (lane & 7) * 4, srcc = coloff + colmap<MAP>(n0 + c4);
        f32x4 v[8];
#pragma unroll
        for (int i = 0; i < 8; ++i) v[i] = __builtin_nontemporal_load((const f32x4*)(W + (size_t)(k0 + 8 * i + (lane >> 3)) * ldw + srcc));
#pragma unroll
        for (int i = 0; i < 8; ++i) { float* d = scr + (8 * i + (lane >> 3)) * 33 + c4; d[0] = v[i].x; d[1] = v[i].y; d[2] = v[i].z; d[3] = v[i].w; }
    }
    asm volatile("s_waitcnt lgkmcnt(0)" ::: "memory");
    const int c = lane & 7;
#pragma unroll
    for (int j = 0; j < 4; ++j) { const int n = (lane >> 3) + 8 * j; const float* s = scr + (8 * c) * 33 + n;
        u32x4 o; o.x = pk2(s[0 * 33], s[1 * 33]); o.y = pk2(s[2 * 33], s[3 * 33]); o.z = pk2(s[4 * 33], s[5 * 33]); o.w = pk2(s[6 * 33], s[7 * 33]);
        __builtin_nontemporal_store(o, (u32x4*)(WT + (size_t)(n0 + n) * K + k0 + 8 * c)); }
    asm volatile("s_waitcnt lgkmcnt(0)" ::: "memory");
}
#define EPI_ROW(ai, m) ((ai) * 128 + wr * 64 + (m) * 16 + fr)
#define EPI_COL(bj, n) ((bj) * 128 + wc * 32 + (n) * 16 + 4 * fq)
#define EPI_COLP(bj) ((bj) * 128 + wc * 32 + 8 * fq)
__device__ __forceinline__ u32x4 pk8(const f32x4 a, const f32x4 b) { return (u32x4){pk2(a.x, a.y), pk2(a.z, a.w), pk2(b.x, b.y), pk2(b.z, b.w)}; }
struct EpiInA { bf16_t* out;
    static constexpr bool PERM = true;
    template <class U> __device__ __forceinline__ void tile(const U& u, const f32x4 (&acc)[2][2][4][2], int wr, int wc, int fr, int fq) const {
#pragma unroll
        for (int bj = 0; bj < 2; ++bj) {
            const int p = u.col0 + EPI_COLP(bj); const int part = (p < 2304) ? ((p % 768) >> 8) : 3;
            const int j0 = (p & 63) >> 1; float f[4];
#pragma unroll
            for (int i = 0; i < 4; ++i) f[i] = __builtin_amdgcn_exp2f(-(float)(j0 + i) * 0.41524101186092034f) * 0.15915494309189535f;
#pragma unroll
            for (int ai = 0; ai < 2; ++ai)
#pragma unroll
                for (int m = 0; m < 4; ++m) { const int row = u.row0 + EPI_ROW(ai, m); f32x4 v[2] = {acc[ai][bj][m][0], acc[ai][bj][m][1]};
                    if (part < 2) { const float pos = (float)(row & (SEQ - 1));
#pragma unroll
                        for (int n = 0; n < 2; ++n) { const float t0 = __builtin_amdgcn_fractf(pos * f[2 * n]), t1 = __builtin_amdgcn_fractf(pos * f[2 * n + 1]);
                            const float c0 = __builtin_amdgcn_cosf(t0), s0 = __builtin_amdgcn_sinf(t0), c1 = __builtin_amdgcn_cosf(t1), s1 = __builtin_amdgcn_sinf(t1);
                            f32x4 o; o.x = v[n].x * c0 - v[n].y * s0; o.y = v[n].y * c0 + v[n].x * s0; o.z = v[n].z * c1 - v[n].w * s1; o.w = v[n].w * c1 + v[n].z * s1; v[n] = o; } }
                    if (part == 0 || part == 3) { v[0] = v[0] * C2; v[1] = v[1] * C2; }
                    const int bb = row >> 11, t = row & (SEQ - 1); size_t off;
                    if (part == 3) off = LA_QM + ((size_t)((bb * 4 + ((p - 2304) >> 6)) * SEQ + t) << 6) + (p & 63);
                    else { const int g = p / 768, hh = ((p - g * 768) >> 6) & 3, dsh = 2 * g, gb = (g * 8 + bb) * 4 + hh;
                        if (part == 0) off = ((size_t)((gb * 16 + (t & 15)) * 128 + (t >> 4)) << 6) + (p & 63);
                        else off = LA_K * part + ((size_t)(gb * SEQ + (t & ((1 << dsh) - 1)) * (SEQ >> dsh) + (t >> dsh)) << 6) + (p & 63); }
                    *(u32x4*)(out + off) = pk8(v[0], v[1]); }
        }
    } };
struct EpiInB { bf16_t* out;
    static constexpr bool PERM = true;
    template <class U> __device__ __forceinline__ void tile(const U& u, const f32x4 (&acc)[2][2][4][2], int wr, int wc, int fr, int fq) const {
#pragma unroll
        for (int ai = 0; ai < 2; ++ai)
#pragma unroll
            for (int m = 0; m < 4; ++m) { const int row = u.row0 + EPI_ROW(ai, m);
#pragma unroll
                for (int bj = 0; bj < 2; ++bj) { const int p = u.col0 + EPI_COLP(bj); const float sc = (p >= 1536) ? C2 : 1.0f;
                    const int reg = p >= 2304 ? 3 : p / 768, pc = p - reg * 768, nh = reg == 3 ? 4 : NFOX, bb = row >> 11, t = row & (SEQ - 1);
                    *(u32x4*)(out + (size_t)reg * LB_V + ((size_t)((bb * nh + (pc >> 6)) * SEQ + t) << 6) + (pc & 63)) = pk8(acc[ai][bj][m][0] * sc, acc[ai][bj][m][1] * sc); } }
    } };
struct EpiPlain { bf16_t* out; int ld; int pad;
    static constexpr bool PERM = true;
    template <class U> __device__ __forceinline__ void tile(const U& u, const f32x4 (&acc)[2][2][4][2], int wr, int wc, int fr, int fq) const {
#pragma unroll
        for (int ai = 0; ai < 2; ++ai)
#pragma unroll
            for (int m = 0; m < 4; ++m) { const int row = u.row0 + EPI_ROW(ai, m);
#pragma unroll
                for (int bj = 0; bj < 2; ++bj) *(u32x4*)(out + (size_t)row * ld + u.col0 + EPI_COLP(bj)) = pk8(acc[ai][bj][m][0], acc[ai][bj][m][1]); }
    } };
struct EpiOut { float* pre; const float* res;
    static constexpr bool PERM = false;
    template <class U> __device__ __forceinline__ void tile(const U& u, const f32x4 (&acc)[2][2][4][2], int wr, int wc, int fr, int fq) const {
#pragma unroll
        for (int ai = 0; ai < 2; ++ai) {
            f32x4 x[4][2][2];
#pragma unroll
            for (int m = 0; m < 4; ++m)
#pragma unroll
                for (int bj = 0; bj < 2; ++bj)
#pragma unroll
                    for (int n = 0; n < 2; ++n) x[m][bj][n] = *(const f32x4*)(res + (size_t)(u.row0 + EPI_ROW(ai, m)) * DM + u.col0 + EPI_COL(bj, n));
#pragma unroll
            for (int m = 0; m < 4; ++m)
#pragma unroll
                for (int bj = 0; bj < 2; ++bj)
#pragma unroll
                    for (int n = 0; n < 2; ++n) *(f32x4*)(pre + (size_t)(u.row0 + EPI_ROW(ai, m)) * DM + u.col0 + EPI_COL(bj, n)) = x[m][bj][n] * DN_ALPHA + acc[ai][bj][m][n];
        }
    } };
struct EpiGU { bf16_t* act; const float* bgu;
    static constexpr bool PERM = true;
    template <class U> __device__ __forceinline__ void tile(const U& u, const f32x4 (&acc)[2][2][4][2], int wr, int wc, int fr, int fq) const {
        f32x4 bg[2], bu[2]; const int j = u.col0 + EPI_COLP(0);
        float ka = -SW_ALPHA * LOG2E, k1 = 1.0f; asm volatile("" : "+v"(ka), "+v"(k1));
        const f32x2 KA = {ka, ka}, K1 = {k1, k1};
#pragma unroll
        for (int n = 0; n < 2; ++n) { bg[n] = *(const f32x4*)(bgu + (size_t)u.e * 2048 + j + 4 * n); bu[n] = *(const f32x4*)(bgu + (size_t)u.e * 2048 + 1024 + j + 4 * n); }
#pragma unroll
        for (int ai = 0; ai < 2; ++ai)
#pragma unroll
            for (int m = 0; m < 4; ++m) { const int row = u.row0 + EPI_ROW(ai, m); f32x4 o[2];
#pragma unroll
                for (int n = 0; n < 2; ++n) { const f32x4 g = acc[ai][0][m][n], up = acc[ai][1][m][n];
#pragma unroll
                    for (int i = 0; i < 4; i += 2) {
                        f32x2 G = (f32x2){g[i], g[i + 1]} + (f32x2){bg[n][i], bg[n][i + 1]}, Uv = (f32x2){up[i], up[i + 1]} + (f32x2){bu[n][i], bu[n][i + 1]};
                        G.x = fminf(G.x, SW_LIMIT); G.y = fminf(G.y, SW_LIMIT);
                        Uv.x = __builtin_amdgcn_fmed3f(Uv.x, -SW_LIMIT, SW_LIMIT); Uv.y = __builtin_amdgcn_fmed3f(Uv.y, -SW_LIMIT, SW_LIMIT);
                        const f32x2 T = G * KA;
                        const f32x2 D = (f32x2){__builtin_amdgcn_exp2f(T.x), __builtin_amdgcn_exp2f(T.y)} + K1;
                        const f32x2 R = {__builtin_amdgcn_rcpf(D.x), __builtin_amdgcn_rcpf(D.y)};
                        const f32x2 O = __builtin_elementwise_fma(Uv, G, G) * R;
                        o[n][i] = O.x; o[n][i + 1] = O.y; } }
                *(u32x4*)(act + (size_t)row * DFF + j) = pk8(o[0], o[1]); }
    } };
struct EpiDN { bf16_t* y; const float* bdn; const float* rowgate;
    static constexpr bool PERM = true;
    template <class U> __device__ __forceinline__ void tile(const U& u, const f32x4 (&acc)[2][2][4][2], int wr, int wc, int fr, int fq) const {
        f32x4 b[2][2]; float g[2][4];
#pragma unroll
        for (int bj = 0; bj < 2; ++bj)
#pragma unroll
            for (int n = 0; n < 2; ++n) b[bj][n] = *(const f32x4*)(bdn + (size_t)u.e * DM + u.col0 + EPI_COLP(bj) + 4 * n);
#pragma unroll
        for (int ai = 0; ai < 2; ++ai)
#pragma unroll
            for (int m = 0; m < 4; ++m) g[ai][m] = rowgate[(size_t)u.e * ECAP + u.idx0 + EPI_ROW(ai, m)];
#pragma unroll
        for (int ai = 0; ai < 2; ++ai)
#pragma unroll
            for (int m = 0; m < 4; ++m) { const int row = u.row0 + EPI_ROW(ai, m);
#pragma unroll
                for (int bj = 0; bj < 2; ++bj) *(u32x4*)(y + (size_t)row * DM + u.col0 + EPI_COLP(bj)) = pk8((acc[ai][bj][m][0] + b[bj][0]) * g[ai][m], (acc[ai][bj][m][1] + b[bj][1]) * g[ai][m]); }
    } };

namespace fg {
#define FG_LAS __attribute__((address_space(3)))
typedef short bf16x8 __attribute__((ext_vector_type(8)));
constexpr int BM = 256, BK = 64, HALF = 128, HTB = HALF * BK * 2, STAGE_BYTES = 8 * HTB, NXCD = 8, WGM = 8;
constexpr int GIDX_OFF = 131072 + 10240;
__host__ __device__ __forceinline__ int lds_byte(int r, int c) { const int st = (r >> 4) * 2 + (c >> 5), rr = r & 15, cc = c & 31, ob = rr * 64 + cc * 2; return st * 1024 + (ob ^ (((ob >> 9) & 1) << 5)); }
__host__ __device__ __forceinline__ void stage_rc(int b, int& R, int& C) { const int st = b / 1024, sb = b % 1024, swz = sb ^ (((sb >> 9) & 1) << 5); R = (st >> 1) * 16 + swz / 64; C = (st & 1) * 32 + (swz % 64) / 2; }

struct FUnit { const bf16_t* B;
               const int* gather; int gcount;
               int arow0;
               int row0, col0, e, idx0; };

struct DenseSched {
    const bf16_t* Bt; int K, nM, nN, nwg, G, c;
    __device__ void init(const bf16_t* Bt_, int M, int N, int K_, int G_, int c_) { Bt = Bt_; K = K_; nM = M / BM; nN = N / BM; nwg = nM * nN; G = G_; c = c_; }
    __device__ __forceinline__ bool next(int i, FUnit& u, int) const {
        const long L = (long)i * G + c; if (L >= nwg) return false;
        int wgid = (int)L; { const int q = nwg / NXCD, r = nwg % NXCD, xcd = wgid % NXCD, off = wgid / NXCD; wgid = (xcd < r ? xcd * (q + 1) : r * (q + 1) + (xcd - r) * q) + off; }
        const int nig = WGM * nN, gid = wgid / nig, fm = gid * WGM, gsz = (nM - fm) < WGM ? (nM - fm) : WGM;
        const int pm = fm + ((wgid % nig) % gsz), pn = (wgid % nig) / gsz;
        u.B = Bt + (size_t)pn * BM * K; u.gather = nullptr; u.gcount = 0; u.arow0 = pm * BM; u.row0 = pm * BM; u.col0 = pn * BM; u.e = 0; u.idx0 = 0; return true;
    }
};
template <int DUAL> struct MoeSched {
    const bf16_t* Wt; const unsigned* cnt; const int* rowtok; const FG_LAS int* pre;
    int G, vcu;
    static constexpr int TN = DUAL ? 8 : 4;
    __device__ __forceinline__ bool next(int i, FUnit& u, int lane) const {
        const int L = i * G + vcu; if (L >= pre[NEXP]) return false;
        const int pv = pre[lane < NEXP ? lane : NEXP];
        const int e = __builtin_popcountll(__ballot(lane < NEXP && L >= pv)) - 1;
        const int loc = L - pre[e], J = (pre[e + 1] - pre[e]) / TN;
        int j, nt; if (DUAL) { const int g = loc / (4 * J), r = loc % (4 * J); j = r >> 2; nt = g * 4 + (r & 3); } else { j = loc >> 2; nt = loc & 3; }
        const int mt = pre[e] / TN + j, c = (int)cnt[e];
        if (DUAL) { u.B = Wt + ((size_t)e * 2048 + nt * 256) * DM; u.gather = rowtok + (size_t)e * ECAP + j * BM; u.gcount = c - j * BM; u.arow0 = 0; u.col0 = nt * 128; }
        else { u.B = Wt + ((size_t)e * 1024 + nt * 256) * DFF; u.gather = nullptr; u.gcount = 0; u.arow0 = mt * BM; u.col0 = nt * 256; }
        u.row0 = mt * BM; u.e = e; u.idx0 = j * BM; return true;
    }
};
__device__ __forceinline__ void moe_prefix(const unsigned* cnt, FG_LAS int* pre, int TN, int tid) {
    if (tid == 0) { int acc = 0; for (int e = 0; e < NEXP; ++e) { pre[e] = acc; acc += (((int)cnt[e] + BM - 1) / BM) * TN; } pre[NEXP] = acc; }
    __syncthreads();
}

template <int DUAL, class Epi, class Sched>
__device__ __forceinline__ void gemm_phase(FG_LAS unsigned char* lds, const bf16_t* A, int K, const Sched& S, const Epi& E, const int tid) {
    const int wid = __builtin_amdgcn_readfirstlane(tid >> 6), lane = tid & 63, wr = wid >> 2, wc = wid & 3, fr = lane & 15, fq = lane >> 4;
    const int nt = K / BK;
    int Rr[2], Cc[2]; unsigned voffB[2];
#pragma unroll
    for (int i = 0; i < 2; ++i) { stage_rc(tid * 16 + i * 8192, Rr[i], Cc[i]);
        const int rho = Rr[i] & 31, Rb = Epi::PERM ? ((Rr[i] & ~31) + 8 * ((rho & 15) >> 2) + 4 * (rho >> 4) + (rho & 3)) : Rr[i];
        voffB[i] = (unsigned)(Rb * K + Cc[i]) * 2u; }
    const size_t kstep = (size_t)(BK * 2);
    const size_t hstep = (size_t)HALF * K * 2;
    const unsigned ldsw = (unsigned)wid * 1024u;
    const int aoff = lds_byte(wr * 64 + fr, fq * 8), boff = lds_byte(wc * 32 + fr, fq * 8);
#define FG_SA(b, h) (((b) * 2 + (h)) * HTB)
#define FG_SB(b, h) ((4 + (b) * 2 + (h)) * HTB)
#define FG_STAGEB(bufoff, gbase) do { _Pragma("unroll") for (int _i = 0; _i < 2; ++_i) \
        __builtin_amdgcn_global_load_lds((const unsigned*)((const char*)(gbase) + voffB[_i]), (FG_LAS unsigned*)(lds + (bufoff) + ldsw + _i * 8192), 16, 0, 0); } while (0)
#define FG_STAGEA(bufoff, o0, o1, kb) do { \
        __builtin_amdgcn_global_load_lds((const unsigned*)((const char*)A + (size_t)(o0) + (kb)), (FG_LAS unsigned*)(lds + (bufoff) + ldsw), 16, 0, 0); \
        __builtin_amdgcn_global_load_lds((const unsigned*)((const char*)A + (size_t)(o1) + (kb)), (FG_LAS unsigned*)(lds + (bufoff) + ldsw + 8192), 16, 0, 0); } while (0)
#define FG_LDA(dst, b, h) do { _Pragma("unroll") for (int m = 0; m < 4; ++m) _Pragma("unroll") for (int k = 0; k < 2; ++k) dst[m][k] = *(const FG_LAS bf16x8*)(lds + FG_SA(b, h) + aoff + m * 2048 + k * 1024); } while (0)
#define FG_LDB(dst, b, h) do { _Pragma("unroll") for (int n = 0; n < 2; ++n) _Pragma("unroll") for (int k = 0; k < 2; ++k) dst[n][k] = *(const FG_LAS bf16x8*)(lds + FG_SB(b, h) + boff + n * 2048 + k * 1024); } while (0)
#define FG_MMA(ai, bj, At, Bt) do { __builtin_amdgcn_s_setprio(1); _Pragma("unroll") for (int m = 0; m < 4; ++m) _Pragma("unroll") for (int n = 0; n < 2; ++n) _Pragma("unroll") for (int k = 0; k < 2; ++k) \
        acc[ai][bj][m][n] = __builtin_amdgcn_mfma_f32_16x16x32_bf16(Bt[n][k], At[m][k], acc[ai][bj][m][n], 0, 0, 0); __builtin_amdgcn_s_setprio(0); } while (0)
#define FG_WAIT_V(n) asm volatile("s_waitcnt vmcnt(" #n ")" ::: "memory")
#define FG_WAIT_L(n) asm volatile("s_waitcnt lgkmcnt(" #n ")" ::: "memory")
#define FG_BAR __builtin_amdgcn_s_barrier()
#define FG_SCHED __builtin_amdgcn_sched_barrier(0)
#define FG_AOFFS(u, dst) do { _Pragma("unroll") for (int h = 0; h < 2; ++h) _Pragma("unroll") for (int i = 0; i < 2; ++i) { const int r_ = h * HALF + Rr[i]; int row_; \
        if ((u).gather) row_ = (r_ < (u).gcount) ? (u).gather[r_] : 0; else row_ = (u).arow0 + r_; dst[h][i] = (unsigned)(row_ * K + Cc[i]) * 2u; } } while (0)
    FUnit cur, nxt; int ui = 0;
    if (!S.next(0, cur, lane)) return;
#ifndef FG_KREP
#define FG_KREP 1
#endif
    f32x4 acc[2][2][4][2];
#pragma unroll
    for (int a = 0; a < 2; ++a)
#pragma unroll
        for (int b = 0; b < 2; ++b)
#pragma unroll
            for (int m = 0; m < 4; ++m)
#pragma unroll
                for (int n = 0; n < 2; ++n) acc[a][b][m][n] = (f32x4){0.f, 0.f, 0.f, 0.f};
    bf16x8 At[4][2], B0[2][2], B1[2][2];
    unsigned ao[2][2], an[2][2];
    FG_AOFFS(cur, ao);
    const char* cB = (const char*)cur.B;
    FG_STAGEB(FG_SB(0, 0), cB); FG_STAGEB(FG_SB(0, 1), cB + hstep); FG_STAGEA(FG_SA(0, 0), ao[0][0], ao[0][1], 0); FG_STAGEA(FG_SA(0, 1), ao[1][0], ao[1][1], 0);
    if (wr == 1) FG_BAR;
    FG_WAIT_V(2); FG_BAR;
    FG_STAGEB(FG_SB(1, 0), cB + kstep); FG_STAGEA(FG_SA(1, 0), ao[0][0], ao[0][1], kstep); FG_STAGEB(FG_SB(1, 1), cB + hstep + kstep);
    FG_WAIT_V(6); FG_BAR;
    for (;;) {
        const bool has_next = S.next((ui + 1) / FG_KREP, nxt, lane);
        const bool nx_gather = has_next && nxt.gather != nullptr;
        if (nx_gather) { if (wid == 0) __builtin_amdgcn_global_load_lds((const unsigned*)(nxt.gather + lane * 4), (FG_LAS unsigned*)(lds + GIDX_OFF), 16, 0, 0); }
        else if (has_next) { FG_AOFFS(nxt, an); } else {
#pragma unroll
            for (int h = 0; h < 2; ++h)
#pragma unroll
                for (int i = 0; i < 2; ++i) an[h][i] = ao[h][i]; }
        const char* nB = has_next ? (const char*)nxt.B : cB;
        for (int t = 0; t < nt; t += 2) {
            const bool last = (t == nt - 2);
            const size_t k1 = (size_t)(t + 1) * kstep, k2 = last ? 0 : (size_t)(t + 2) * kstep, k3 = k2 + kstep;
            const char* b2 = (last ? nB : cB) + k2; const char* b3 = b2 + kstep;
            if (last && nx_gather) {
#pragma unroll
                for (int h = 0; h < 2; ++h)
#pragma unroll
                    for (int i = 0; i < 2; ++i) { const int r_ = h * HALF + Rr[i]; const int row_ = (r_ < nxt.gcount) ? *(const FG_LAS int*)(lds + GIDX_OFF + r_ * 4) : 0; an[h][i] = (unsigned)(row_ * K + Cc[i]) * 2u; } }
            const unsigned s00 = last ? an[0][0] : ao[0][0], s01 = last ? an[0][1] : ao[0][1], s10 = last ? an[1][0] : ao[1][0], s11 = last ? an[1][1] : ao[1][1];
            FG_LDB(B0, 0, 0); FG_LDB(B1, 0, 1); FG_SCHED; FG_LDA(At, 0, 0); FG_STAGEA(FG_SA(1, 1), ao[1][0], ao[1][1], k1);
            FG_WAIT_V(8); FG_WAIT_L(0); FG_BAR; FG_MMA(0, 0, At, B0); FG_MMA(0, 1, At, B1); FG_BAR; FG_SCHED;
            FG_LDA(At, 0, 1); FG_STAGEB(FG_SB(0, 0), b2); FG_STAGEB(FG_SB(0, 1), b2 + hstep); FG_STAGEA(FG_SA(0, 0), s00, s01, k2);
            FG_WAIT_V(8); FG_WAIT_L(0); FG_BAR; FG_MMA(1, 0, At, B0); FG_MMA(1, 1, At, B1); FG_BAR; FG_SCHED;
            FG_LDB(B0, 1, 0); FG_LDB(B1, 1, 1); FG_SCHED; FG_LDA(At, 1, 0); FG_STAGEA(FG_SA(0, 1), s10, s11, k2);
            FG_WAIT_V(8); FG_WAIT_L(0); FG_BAR; FG_MMA(0, 0, At, B0); FG_MMA(0, 1, At, B1); FG_BAR; FG_SCHED;
            FG_LDA(At, 1, 1); FG_STAGEB(FG_SB(1, 0), b3); FG_STAGEB(FG_SB(1, 1), b3 + hstep); FG_STAGEA(FG_SA(1, 0), s00, s01, k3);
            FG_WAIT_V(8); FG_WAIT_L(0); FG_BAR; FG_MMA(1, 0, At, B0); FG_MMA(1, 1, At, B1); FG_BAR; FG_SCHED;
        }
        if (wr == 0) FG_BAR;
        if (ui % FG_KREP == FG_KREP - 1) E.tile(cur, acc, wr, wc, fr, fq);
        if (!has_next) break;
#pragma unroll
        for (int a = 0; a < 2; ++a)
#pragma unroll
            for (int b = 0; b < 2; ++b)
#pragma unroll
                for (int m = 0; m < 4; ++m)
#pragma unroll
                    for (int n = 0; n < 2; ++n) acc[a][b][m][n] = (f32x4){0.f, 0.f, 0.f, 0.f};
        cur = nxt; cB = nB; ++ui;
#pragma unroll
        for (int h = 0; h < 2; ++h)
#pragma unroll
            for (int i = 0; i < 2; ++i) ao[h][i] = an[h][i];
        if (wr == 1) FG_BAR;
    }
    FG_WAIT_V(0);
    FG_BAR;
#undef FG_SA
#undef FG_SB
#undef FG_STAGEA
#undef FG_STAGEB
#undef FG_LDA
#undef FG_LDB
#undef FG_MMA
#undef FG_WAIT_V
#undef FG_WAIT_L
#undef FG_BAR
#undef FG_SCHED
#undef FG_AOFFS
}
}
constexpr int FAST_LDS = 147456;
constexpr int MISC_OFF = 131072;
__device__ __forceinline__ int vcu_of(int bx, int G) { return (G % 8 == 0) ? (bx % 8) * (G / 8) + bx / 8 : bx; }

namespace at {
#define AT_LAS __attribute__((address_space(3)))
typedef short bf16x8 __attribute__((ext_vector_type(8)));
typedef short s16x4 __attribute__((ext_vector_type(4)));
typedef short v4i16_t __attribute__((ext_vector_type(4)));
typedef float f32x16 __attribute__((ext_vector_type(16)));
typedef __bf16 bf16x2_t __attribute__((ext_vector_type(2)));
__device__ __forceinline__ unsigned cvtpk(float lo, float hi) { f32x2 v = {lo, hi}; bf16x2_t b = __builtin_convertvector(v, bf16x2_t); return __builtin_bit_cast(unsigned, b); }
__device__ __forceinline__ s16x4 vtr(const AT_LAS char* p) { return __builtin_bit_cast(s16x4, __builtin_amdgcn_ds_read_tr16_b64_v4i16((AT_LAS v4i16_t*)p)); }
__device__ __forceinline__ void glds16(const void* g, AT_LAS char* l) { unsigned keep; const unsigned dst = (unsigned)__builtin_amdgcn_readfirstlane((int)(unsigned)(uintptr_t)l);
    asm volatile("s_mov_b32 %0, m0\n\ts_mov_b32 m0, %2\n\ts_nop 0\n\tglobal_load_lds_dwordx4 %1, off\n\ts_mov_b32 m0, %0" : "=&s"(keep) : "v"(g), "s"(dst) : "memory"); }
__device__ __forceinline__ void glds16x4(unsigned voff, const void* sbase, AT_LAS char* l) { unsigned keep; const unsigned dst = (unsigned)__builtin_amdgcn_readfirstlane((int)(unsigned)(uintptr_t)l);
    asm volatile("s_mov_b32 %0, m0\n\ts_mov_b32 m0, %3\n\ts_nop 0\n\tglobal_load_lds_dwordx4 %1, %2\n\tglobal_load_lds_dwordx4 %1, %2 offset:1024\n\tglobal_load_lds_dwordx4 %1, %2 offset:2048\n\tglobal_load_lds_dwordx4 %1, %2 offset:3072\n\ts_mov_b32 m0, %0"
                 : "=&s"(keep) : "v"(voff), "s"(sbase), "s"(dst) : "memory"); }
__device__ __forceinline__ void glds16x2(unsigned voff, const void* sbase, AT_LAS char* l) { unsigned keep; const unsigned dst = (unsigned)__builtin_amdgcn_readfirstlane((int)(unsigned)(uintptr_t)l);
    asm volatile("s_mov_b32 %0, m0\n\ts_mov_b32 m0, %3\n\ts_nop 0\n\tglobal_load_lds_dwordx4 %1, %2\n\tglobal_load_lds_dwordx4 %1, %2 offset:2048\n\ts_mov_b32 m0, %0"
                 : "=&s"(keep) : "v"(voff), "s"(sbase), "s"(dst) : "memory"); }
__device__ __forceinline__ float swapmax(float x) { auto rr = __builtin_amdgcn_permlane32_swap(__float_as_uint(x), __float_as_uint(x), false, false); return fmaxf(__uint_as_float(rr[0]), __uint_as_float(rr[1])); }
__device__ __forceinline__ float swapsum(float x) { auto rr = __builtin_amdgcn_permlane32_swap(__float_as_uint(x), __float_as_uint(x), false, false); return __uint_as_float(rr[0]) + __uint_as_float(rr[1]); }
__device__ __forceinline__ f32x16 qk32(const AT_LAS char* kblk, const bf16x8 (&qr)[4], int r32, int hi) {
    bf16x8 a[4]; const AT_LAS char* rp = kblk + r32 * 128; const int x = r32 & 7;
#pragma unroll
    for (int d0 = 0; d0 < 4; ++d0) a[d0] = *(const AT_LAS bf16x8*)(rp + (((2 * d0 + hi) ^ x) << 4));
    f32x16 p = {};
#pragma unroll
    for (int d0 = 0; d0 < 4; ++d0) p = __builtin_amdgcn_mfma_f32_32x32x16_bf16(a[d0], qr[d0], p, 0, 0, 0);
    return p;
}
__device__ __forceinline__ void qk64(f32x16& p0, f32x16& p1, const AT_LAS char* kt, const bf16x8 (&qr)[4], int r32, int hi) {
    bf16x8 a[4], b[4]; const AT_LAS char* rp = kt + r32 * 128; const int x = r32 & 7;
#pragma unroll
    for (int d0 = 0; d0 < 4; ++d0) { const int so = ((2 * d0 + hi) ^ x) << 4; a[d0] = *(const AT_LAS bf16x8*)(rp + so); b[d0] = *(const AT_LAS bf16x8*)(rp + 4096 + so); }
    p0 = f32x16{}; p1 = f32x16{};
#pragma unroll
    for (int d0 = 0; d0 < 4; ++d0) { p0 = __builtin_amdgcn_mfma_f32_32x32x16_bf16(a[d0], qr[d0], p0, 0, 0, 0); p1 = __builtin_amdgcn_mfma_f32_32x32x16_bf16(b[d0], qr[d0], p1, 0, 0, 0); }
}
__device__ __forceinline__ void pack_p(const f32x16& p, bf16x8& pa0, bf16x8& pa1) {
    u32x4 w0, w1;
    w0.x = cvtpk(p[0], p[1]); w0.y = cvtpk(p[2], p[3]); w0.z = cvtpk(p[4], p[5]); w0.w = cvtpk(p[6], p[7]);
    w1.x = cvtpk(p[8], p[9]); w1.y = cvtpk(p[10], p[11]); w1.z = cvtpk(p[12], p[13]); w1.w = cvtpk(p[14], p[15]);
    pa0 = __builtin_bit_cast(bf16x8, w0); pa1 = __builtin_bit_cast(bf16x8, w1);
}
__device__ __forceinline__ void v_lane_offs(int lane, int hi, int (&a)[2]) {
    const int q = (lane & 15) >> 2, cl = 2 * ((lane >> 4) & 1) + ((lane & 3) >> 1), sub = (lane & 1) * 8;
#pragma unroll
    for (int sec = 0; sec < 2; ++sec) { const int kl = 4 * hi + q + 8 * sec; a[sec] = kl * 128 + ((cl ^ ((kl >> 1) & 7)) << 4) + sub; }
}
template <int NKS> __device__ __forceinline__ void pv_tile(f32x16 (&o)[2], const bf16x8 (&pa)[NKS], const AT_LAS char* vt, int lane, int hi) {
    int a[2]; v_lane_offs(lane, hi, a);
    s16x4 lo[2][NKS], hh[2][NKS];
#pragma unroll
    for (int d0 = 0; d0 < 2; ++d0)
#pragma unroll
        for (int ks = 0; ks < NKS; ++ks) { lo[d0][ks] = vtr(vt + ks * 2048 + (a[0] ^ (d0 * 64))); hh[d0][ks] = vtr(vt + ks * 2048 + (a[1] ^ (d0 * 64))); }
#pragma unroll
    for (int ks = 0; ks < NKS; ++ks)
#pragma unroll
        for (int d0 = 0; d0 < 2; ++d0) { const bf16x8 b = (bf16x8){lo[d0][ks][0], lo[d0][ks][1], lo[d0][ks][2], lo[d0][ks][3], hh[d0][ks][0], hh[d0][ks][1], hh[d0][ks][2], hh[d0][ks][3]};
            o[d0] = __builtin_amdgcn_mfma_f32_32x32x16_bf16(pa[ks], b, o[d0], 0, 0, 0); }
}
__device__ __forceinline__ void pv32(f32x16 (&o)[2], const f32x16& p, const AT_LAS char* vt, int lane, int hi) { bf16x8 pa[2]; pack_p(p, pa[0], pa[1]); pv_tile<2>(o, pa, vt, lane, hi); }
__device__ __forceinline__ void pv64(f32x16 (&o)[2], const f32x16& p0, const f32x16& p1, const AT_LAS char* vt, int lane, int hi) { bf16x8 pa[4]; pack_p(p0, pa[0], pa[1]); pack_p(p1, pa[2], pa[3]); pv_tile<4>(o, pa, vt, lane, hi); }
template <int NBK> __device__ __forceinline__ void softmax_step(f32x16 (&p)[NBK], float& m, float& l, f32x16 (&o)[2], AT_LAS float* wsf, int r32, int hi) {
    float mt = p[0][0];
#pragma unroll
    for (int b = 0; b < NBK; ++b)
#pragma unroll
        for (int r = 0; r < 16; ++r) mt = fmaxf(mt, p[b][r]);
    mt = swapmax(mt);
    const float mn = fmaxf(m, mt);
    if (__any(mt > m + 4.0f)) {
        const float alpha = __builtin_amdgcn_exp2f(m - mn);
        l *= alpha;
        if (hi == 0) wsf[r32] = alpha;
#pragma unroll
        for (int g = 0; g < 4; ++g) { const f32x4 a = *(const AT_LAS f32x4*)(wsf + 8 * g + 4 * hi);
#pragma unroll
            for (int i = 0; i < 4; ++i) { o[0][4 * g + i] *= a[i]; o[1][4 * g + i] *= a[i]; } }
        m = mn;
    }
    float s = 0.f;
#pragma unroll
    for (int b = 0; b < NBK; ++b)
#pragma unroll
        for (int r = 0; r < 16; ++r) { p[b][r] = __builtin_amdgcn_exp2f(p[b][r] - m); s += p[b][r]; }
    l += s;
}
__device__ __forceinline__ void attn_store(const f32x16 (&o)[2], float l, AT_LAS float* wsf, AT_LAS bf16_t* stg, bf16_t* Og, size_t rs, int lane, int r32, int hi) {
    const float lt = swapsum(l);
    if (hi == 0) wsf[32 + r32] = 1.0f / lt;
#pragma unroll
    for (int g = 0; g < 4; ++g) { const f32x4 rl = *(const AT_LAS f32x4*)(wsf + 32 + 8 * g + 4 * hi);
#pragma unroll
        for (int i = 0; i < 4; ++i) { const int orow = 8 * g + 4 * hi + i;
            stg[orow * 64 + r32] = (bf16_t)f2bf(o[0][4 * g + i] * rl[i]); stg[orow * 64 + 32 + r32] = (bf16_t)f2bf(o[1][4 * g + i] * rl[i]); } }
#pragma unroll
    for (int i = 0; i < 4; ++i) { const int row = i * 8 + (lane >> 3), ch = lane & 7; const u32x4 v = *(const AT_LAS u32x4*)(stg + row * 64 + ch * 8); *(u32x4*)(Og + (size_t)row * rs + ch * 8) = v; }
}

constexpr int NRING = 4, LK = 0, LV = NRING * 8192, LW = 2 * NRING * 8192, LO = LW + 2048, LC = LO + 8 * 4096, ATT_LDS = LC + NRING * 1024;
__device__ __forceinline__ void qk64x(f32x16& p0, f32x16& p1, const AT_LAS char* kt, const bf16x8 (&qr)[4], const bf16x8 ax0, const bf16x8 ax1, const bf16x8 qx, int r32, int hi) {
    bf16x8 a[4], b[4]; const AT_LAS char* rp = kt + r32 * 128; const int x = r32 & 7;
#pragma unroll
    for (int d0 = 0; d0 < 4; ++d0) { const int so = ((2 * d0 + hi) ^ x) << 4; a[d0] = *(const AT_LAS bf16x8*)(rp + so); b[d0] = *(const AT_LAS bf16x8*)(rp + 4096 + so); }
    p0 = __builtin_amdgcn_mfma_f32_32x32x16_bf16(ax0, qx, (f32x16){}, 0, 0, 0); p1 = __builtin_amdgcn_mfma_f32_32x32x16_bf16(ax1, qx, (f32x16){}, 0, 0, 0);
#pragma unroll
    for (int d0 = 0; d0 < 4; ++d0) { p0 = __builtin_amdgcn_mfma_f32_32x32x16_bf16(a[d0], qr[d0], p0, 0, 0, 0); p1 = __builtin_amdgcn_mfma_f32_32x32x16_bf16(b[d0], qr[d0], p1, 0, 0, 0); }
}
__device__ __forceinline__ bf16x8 make_qx(float cm, int hi) {
    const unsigned hb = cvtpk(cm, 0.f) & 0xffffu; const float hf = __uint_as_float(hb << 16); const unsigned lb = cvtpk(cm - hf, 0.f) & 0xffffu;
    u32x4 w = (u32x4){hb | (lb << 16), 0x3F803F80u, 0u, 0u}; if (hi) w = (u32x4){0u, 0u, 0u, 0u};
    return __builtin_bit_cast(bf16x8, w);
}
constexpr float AT_THR = 4.0f;
template <int MODE> __device__ __forceinline__ void attn_block_unit(AT_LAS char* lds, const bf16_t* Qp, int ldq, const bf16_t* Kp, const bf16_t* Vp, int ldkv, int NT, int q0, const float* cl, const bf16_t* ckb, bf16_t* Op, int ldo, const int tid) {
    const int lane = tid & 63, r32 = lane & 31, hi = lane >> 5; const int wid = __builtin_amdgcn_readfirstlane(tid >> 6);
    AT_LAS float* wsf = (AT_LAS float*)(lds + LW) + wid * 64; AT_LAS bf16_t* stg = (AT_LAS bf16_t*)(lds + LO) + wid * 2048;
    const int qpos = q0 + wid * 32 + r32;
    const int lrow = wid * 8 + (lane >> 3), lslot = lane & 7;
    const bf16_t* ksrc = Kp + (size_t)lrow * ldkv + ((lslot ^ (lrow & 7)) << 3);
    const bf16_t* vsrc = Vp + (size_t)lrow * ldkv + ((lslot ^ ((lrow >> 1) & 7)) << 3);
    const bool xw = (MODE == 0) && (wid == 0);
#define AT_LOAD(t, bs) do { const int tt_ = NT - 1 - (t); const size_t to_ = (size_t)tt_ * 64 * ldkv; glds16(ksrc + to_, lds + LK + (bs) * 8192 + wid * 1024); glds16(vsrc + to_, lds + LV + (bs) * 8192 + wid * 1024); \
        if (xw) glds16(ckb + ((size_t)(tt_ * 64 + lane) << 3), lds + LC + (bs) * 1024); } while (0)
#define AT_WAITN(n) do { if (xw) { if ((n) >= 2) asm volatile("s_waitcnt vmcnt(6) lgkmcnt(0)" ::: "memory"); else if ((n) == 1) asm volatile("s_waitcnt vmcnt(3) lgkmcnt(0)" ::: "memory"); else asm volatile("s_waitcnt vmcnt(0) lgkmcnt(0)" ::: "memory"); } \
        else { if ((n) >= 2) asm volatile("s_waitcnt vmcnt(4) lgkmcnt(0)" ::: "memory"); else if ((n) == 1) asm volatile("s_waitcnt vmcnt(2) lgkmcnt(0)" ::: "memory"); else asm volatile("s_waitcnt vmcnt(0) lgkmcnt(0)" ::: "memory"); } } while (0)
    AT_LOAD(0, 0); if (NT > 1) AT_LOAD(1, 1); if (NT > 2) AT_LOAD(2, 2);
    bf16x8 qr[4];
#pragma unroll
    for (int d0 = 0; d0 < 4; ++d0) qr[d0] = *(const bf16x8*)(Qp + (size_t)qpos * ldq + d0 * 16 + hi * 8);
    float l = 0.f, cq = 0.f; if (MODE == 0) cq = cl[qpos];
    f32x16 o[2]; o[0] = f32x16{}; o[1] = f32x16{};
#pragma unroll
    for (int d0 = 0; d0 < 4; ++d0) asm volatile("" : "+v"(qr[d0]));
    asm volatile("" : "+v"(cq));
    float cm = cq;
    bf16x8 qx = make_qx(cm, hi);
    unsigned one2 = 0x3F803F80u, zz = 0u; asm volatile("" : "+v"(one2), "+v"(zz));
    const bf16x8 ax_const = __builtin_bit_cast(bf16x8, (u32x4){one2, zz, zz, zz});
    bool first = true;
#define AT_WAIT1(more) do { if (more) { if (xw) asm volatile("s_waitcnt vmcnt(3) lgkmcnt(0)" ::: "memory"); else asm volatile("s_waitcnt vmcnt(2) lgkmcnt(0)" ::: "memory"); } else asm volatile("s_waitcnt vmcnt(0) lgkmcnt(0)" ::: "memory"); } while (0)
#define AT_LIVE(t_) ((MODE == 1) || ((NT - 1 - (t_)) * 64 <= q0 + wid * 32 + 31))
#define AT_QK(t_, P) do { const int bq_ = (t_) & (NRING - 1), kq_ = (NT - 1 - (t_)) * 64; bf16x8 ax0_ = ax_const, ax1_ = ax_const; \
        if (MODE == 0) { ax0_ = *(const AT_LAS bf16x8*)(lds + LC + bq_ * 1024 + r32 * 16); ax1_ = *(const AT_LAS bf16x8*)(lds + LC + bq_ * 1024 + 512 + r32 * 16); } \
        qk64x(P[0], P[1], lds + LK + bq_ * 8192, qr, ax0_, ax1_, qx, r32, hi); \
        if (MODE == 0 && kq_ + 63 > q0 + wid * 32) {                                      \
            _Pragma("unroll") for (int b = 0; b < 2; ++b) _Pragma("unroll") for (int r = 0; r < 16; ++r) { const int key = kq_ + b * 32 + (r & 3) + 8 * (r >> 2) + 4 * hi; if (key > qpos) P[b][r] = -INFINITY; } } } while (0)
#define AT_STEP(t_, PC, PN) do { const int bs = (t_) & (NRING - 1); \
        if ((t_) + 3 < NT) AT_LOAD((t_) + 3, ((t_) + 3) & (NRING - 1));                   \
        const bool ln_ = ((t_) + 1 < NT) && AT_LIVE((t_) + 1); \
        if (ln_) AT_QK((t_) + 1, PN); \
        if (AT_LIVE(t_)) { \
            float mt = PC[0][0]; \
            _Pragma("unroll") for (int b = 0; b < 2; ++b) _Pragma("unroll") for (int r = 0; r < 16; ++r) mt = fmaxf(mt, PC[b][r]); \
            mt = swapmax(mt); \
            if (first || __any(mt > AT_THR)) {                                            \
                const float dl = first ? mt : fmaxf(mt, 0.f); \
                cm -= dl; qx = make_qx(cm, hi); \
                _Pragma("unroll") for (int b = 0; b < 2; ++b) _Pragma("unroll") for (int r = 0; r < 16; ++r) PC[b][r] -= dl; \
                if (ln_) { _Pragma("unroll") for (int b = 0; b < 2; ++b) _Pragma("unroll") for (int r = 0; r < 16; ++r) PN[b][r] -= dl; } \
                if (!first) { const float alpha = __builtin_amdgcn_exp2f(-dl); l *= alpha; \
                    if (hi == 0) wsf[r32] = alpha; \
                    _Pragma("unroll") for (int g = 0; g < 4; ++g) { const f32x4 a = *(const AT_LAS f32x4*)(wsf + 8 * g + 4 * hi); \
                        _Pragma("unroll") for (int i = 0; i < 4; ++i) { o[0][4 * g + i] *= a[i]; o[1][4 * g + i] *= a[i]; } } } \
                first = false; \
            } \
            float sm = 0.f; \
            _Pragma("unroll") for (int b = 0; b < 2; ++b) _Pragma("unroll") for (int r = 0; r < 16; ++r) { PC[b][r] = __builtin_amdgcn_exp2f(PC[b][r]); sm += PC[b][r]; } \
            l += sm; \
            pv64(o, PC[0], PC[1], lds + LV + bs * 8192, lane, hi); \
        } \
        AT_WAIT1((t_) + 3 < NT);                                                           \
        __builtin_amdgcn_s_barrier(); } while (0)
    AT_WAIT1(NT > 2);
    __builtin_amdgcn_s_barrier();
    f32x16 pa[2], pb[2];
    if (AT_LIVE(0)) AT_QK(0, pa);
    for (int t = 0; t < NT; t += 2) { AT_STEP(t, pa, pb); AT_STEP(t + 1, pb, pa); }
#undef AT_STEP
#undef AT_QK
#undef AT_LIVE
#undef AT_WAIT1
#undef AT_LOAD
#undef AT_WAITN
    attn_store(o, l, wsf, stg, Op + (size_t)(q0 + wid * 32) * ldo, (size_t)ldo, lane, r32, hi);
}

constexpr int DW_BYTES = 16384;
__device__ __forceinline__ void attn_dil_wave(AT_LAS char* lds0, AT_LAS char* wl, AT_LAS float* wsf, const bf16_t* QKV, bf16_t* MERGED, int b, int hh, int ib, int rho, int lane) {
    const int r32 = lane & 31, hi = lane >> 5, w8 = rho & 7, h8 = rho >> 3;
    float m = -1e30f, l = 0.f; f32x16 o[2]; o[0] = f32x16{}; o[1] = f32x16{};
    const size_t rowb = (size_t)b * SEQ;
    const unsigned vK = (unsigned)((lane >> 3) * 128 + (((lane & 7) ^ ((lane >> 3) & 7)) << 4)), vV0 = (unsigned)((lane >> 3) * 128 + (((lane & 7) ^ (lane >> 4)) << 4)), vV1 = (unsigned)((lane >> 3) * 128 + (((lane & 7) ^ ((lane >> 4) + 4)) << 4));
#define AT_DLOAD(KB, LO, tt, bs) do { AT_LAS char* bb_ = wl + (bs) * 8192; const char* kt_ = (const char*)(KB) + (size_t)((LO) + 32 * (tt)) * 128; \
            at::glds16x4(vK, kt_, bb_); at::glds16x2(vV0, kt_ + LA_K * 2, bb_ + 4096); at::glds16x2(vV1, kt_ + LA_K * 2 + 1024, bb_ + 4096 + 1024); } while (0)
#define AT_DTILES(QR, KB, LO, NTILE, LQ) do { \
        AT_DLOAD(KB, LO, 0, 0); \
        asm volatile("s_waitcnt vmcnt(0)" ::: "memory"); \
        for (int tt = 0; tt < (NTILE); ++tt) { \
            const int bs = tt & 1; \
            if (tt + 1 < (NTILE)) AT_DLOAD(KB, LO, tt + 1, bs ^ 1); \
            f32x16 p[1]; p[0] = qk32(wl + bs * 8192, QR, r32, hi); \
            const unsigned rel = (unsigned)((LO) + 32 * tt + 4 * hi - ((LQ) - 128));        \
            _Pragma("unroll") for (int r = 0; r < 16; ++r) { if (rel + (unsigned)((r & 3) + 8 * (r >> 2)) > 128u) p[0][r] = -INFINITY; } \
            softmax_step<1>(p, m, l, o, wsf, r32, hi); \
            pv32(o, p[0], wl + bs * 8192 + 4096, lane, hi); \
            asm volatile("s_waitcnt vmcnt(0) lgkmcnt(0)" ::: "memory"); \
        } } while (0)
    {
        const int j = r32 >> 3, r = r32 & 7, i0 = 4 * w8 + j, rho0 = 8 * h8 + r;
        const int lq = 16 * (32 * ib + i0) + rho0;
        const int tmin = 16 * (32 * ib + 4 * w8) + 8 * h8, lo = tmin > 128 ? tmin - 128 : 0, hiL = tmin + 55, ntile = ((hiL - lo) >> 5) + 1;
        const int gb = b * 4 + hh;
        const bf16_t* qrow = QKV + ((size_t)((gb * 16 + rho0) * 128 + 32 * ib + i0) << 6);
        const bf16_t* kbase = QKV + LA_K + ((size_t)(gb * SEQ) << 6);
        bf16x8 qr[4];
#pragma unroll
        for (int d0 = 0; d0 < 4; ++d0) qr[d0] = *(const bf16x8*)(qrow + d0 * 16 + hi * 8);
        AT_DTILES(qr, kbase, lo, ntile, lq);
        __syncthreads();
        AT_LAS float* X = (AT_LAS float*)lds0; AT_LAS float* ML = X + 8 * 32 * 64;
#pragma unroll
        for (int jj = 0; jj < 16; ++jj) { const int qh = (jj & 3) + 8 * (jj >> 2) + 4 * hi, dst = ((qh & 7) * 32 + 4 * w8 + (qh >> 3)) * 64 + r32;
            X[dst] = o[0][jj]; X[dst + 32] = o[1][jj]; }
        *(AT_LAS f32x2*)(ML + ((r * 32 + i0) * 2 + hi) * 2) = (f32x2){m, l};
        __syncthreads();
#pragma unroll
        for (int jj = 0; jj < 16; ++jj) { const int row = (jj & 3) + 8 * (jj >> 2) + 4 * hi, src = (w8 * 32 + row) * 64 + r32;
            o[0][jj] = X[src]; o[1][jj] = X[src + 32]; }
        { const f32x2 ml = *(const AT_LAS f32x2*)(ML + ((w8 * 32 + r32) * 2 + hi) * 2); m = ml.x; l = ml.y; }
        __syncthreads();
    }
    for (int g = 1; g < 3; ++g) {
        const int dsh = 2 * g, d = 1 << dsh, sigma = 16 >> dsh, rd = rho & (d - 1), rhod = rho >> dsh;
        const int lq = sigma * (32 * ib + r32) + rhod;
        const int lq0 = sigma * 32 * ib + rhod, lo = lq0 > 128 ? lq0 - 128 : 0, hiL = lq0 + 31 * sigma, ntile = ((hiL - lo) >> 5) + 1;
        const int gb = (g * 8 + b) * 4 + hh;
        const bf16_t* qbase = QKV + ((size_t)((gb * 16 + rho) * 128 + 32 * ib) << 6);
        const bf16_t* kbase = QKV + LA_K + ((size_t)(gb * SEQ + rd * (SEQ >> dsh)) << 6);
        bf16x8 qr[4];
#pragma unroll
        for (int d0 = 0; d0 < 4; ++d0) qr[d0] = *(const bf16x8*)(qbase + r32 * 64 + d0 * 16 + hi * 8);
        AT_DTILES(qr, kbase, lo, ntile, lq);
    }
#undef AT_DTILES
#undef AT_DLOAD
    attn_store(o, l, wsf, (AT_LAS bf16_t*)wl, MERGED + (rowb + 16 * 32 * ib + rho) * A_OUT + hh * 64, (size_t)16 * A_OUT, lane, r32, hi);
}
}

__device__ __forceinline__ void phase_attn_a(AT_LAS char* lds, const bf16_t* QKV, const bf16_t* MKV, bf16_t* MERGED, int G, int vcu, const int tid) {
    const int lane = tid & 63, wid = __builtin_amdgcn_readfirstlane(tid >> 6);
    for (int un = vcu; un < 256; un += G) {
        const int b = un >> 5, hh = (un >> 3) & 3, ib = (un >> 1) & 3, rho = (un & 1) * 8 + wid;
        at::attn_dil_wave(lds, lds + wid * at::DW_BYTES, (AT_LAS float*)(lds + 131072 + 8192 + wid * 256), QKV, MERGED, b, hh, ib, rho, lane);
    }
    __syncthreads();
    for (int un = vcu; un < 256; un += G) {
        const int b = un >> 5, h = (un >> 3) & 3, qb = un & 7;
        at::attn_block_unit<1>(lds, QKV + LA_QM + ((size_t)((b * 4 + h) * SEQ) << 6), 64, MKV + (size_t)b * MEM_LEN * 512 + h * 64, MKV + (size_t)b * MEM_LEN * 512 + 256 + h * 64, 512, 4, qb * 256, nullptr, nullptr,
                                 MERGED + (size_t)b * SEQ * A_OUT + 256 + h * 64, A_OUT, tid);
    }
}
__device__ __forceinline__ void fox_unit(AT_LAS char* lds, const bf16_t* QKV, const float* CUM, const bf16_t* CKB, bf16_t* MERGED, int bh, int qb, const int tid) {
    const int b = bh / NFOX, h = bh % NFOX;
    const size_t ho = (size_t)(bh * SEQ) << 6;
    at::attn_block_unit<0>(lds, QKV + LB_QF + ho, 64, QKV + ho, QKV + LB_V + ho, 64, 4 * (qb + 1), qb * 256,
                             CUM + (size_t)bh * SEQ, CKB + ((size_t)bh * SEQ << 3), MERGED + (size_t)b * SEQ * B_OUT + h * 64, B_OUT, tid);
}
__device__ __forceinline__ void phase_attn_b(AT_LAS char* lds, const bf16_t* QKV, const float* CUM, const bf16_t* CKB, const bf16_t* MKV, bf16_t* MERGED, int G, int vcu, const int tid) {
    if (G == 256) {
        const int grp = vcu >> 3, s = vcu & 7;
        const unsigned tq[8] = {0x704000u, 0x713010u, 0x722011u, 0x605001u, 0x614102u, 0x623121u, 0x514212u, 0x523222u};
        unsigned code = 0;
#pragma unroll
        for (int i = 0; i < 8; ++i) if (s == i) code = tq[i];
#pragma unroll 1
        for (int k = 0; k < 3; ++k) { const int qb = (code >> (20 - 8 * k)) & 15, pr = (code >> (16 - 8 * k)) & 15; fox_unit(lds, QKV, CUM, CKB, MERGED, grp * 3 + pr, qb, tid); }
    } else {
        for (int un = vcu; un < NB * NFOX * 8; un += G) { const int qb = 7 - un / (NB * NFOX), bh = un % (NB * NFOX); fox_unit(lds, QKV, CUM, CKB, MERGED, bh, qb, tid); }
    }
    for (int un = vcu; un < 256; un += G) {
        const int b = un >> 5, h = (un >> 3) & 3, qb = un & 7;
        at::attn_block_unit<1>(lds, QKV + LB_QM + ((size_t)((b * 4 + h) * SEQ) << 6), 64, MKV + (size_t)b * MEM_LEN * 512 + h * 64, MKV + (size_t)b * MEM_LEN * 512 + 256 + h * 64, 512, 4, qb * 256, nullptr, nullptr,
                                 MERGED + (size_t)b * SEQ * B_OUT + 768 + h * 64, B_OUT, tid);
    }
}
__device__ __forceinline__ void load_wT(float* wT, const float* W, int ldw, int coloff, int nw, int tid) {
    const int nch = nw >> 2;
    for (int i = tid; i < DM * nch; i += 512) { const int d = i & (DM - 1), k = i >> 10; const f32x4 w = *(const f32x4*)(W + (size_t)d * ldw + coloff + 4 * k);
        wT[(4 * k + 0) * DM + d] = w.x; wT[(4 * k + 1) * DM + d] = w.y; wT[(4 * k + 2) * DM + d] = w.z; wT[(4 * k + 3) * DM + d] = w.w; }
}
__device__ __forceinline__ void ln_rows(f32x4 (&v)[4], const float* g, const float* b, int lane) {
    float s = 0.f, q = 0.f;
#pragma unroll
    for (int j = 0; j < 4; ++j) { s += (v[j].x + v[j].y) + (v[j].z + v[j].w); q += (v[j].x * v[j].x + v[j].y * v[j].y) + (v[j].z * v[j].z + v[j].w * v[j].w); }
#pragma unroll
    for (int o = 1; o < 64; o <<= 1) { s += shx(s, o, lane); q += shx(q, o, lane); }
    const float mean = s * (1.f / DM), var = fmaxf(q * (1.f / DM) - mean * mean, 0.f);
    const float rstd = 1.0f / sqrtf(var + LN_EPS);
#pragma unroll
    for (int j = 0; j < 4; ++j) { const f32x4 gg = ((const f32x4*)g)[64 * j + lane], bb = ((const f32x4*)b)[64 * j + lane]; v[j] = (v[j] - mean) * rstd * gg + bb; }
}
__device__ __forceinline__ void ln_rows2(f32x4 (&v0)[4], f32x4 (&v1)[4], const float* g, const float* b, int lane) {
    float s0 = 0.f, q0 = 0.f, s1 = 0.f, q1 = 0.f;
#pragma unroll
    for (int j = 0; j < 4; ++j) { s0 += (v0[j].x + v0[j].y) + (v0[j].z + v0[j].w); q0 += (v0[j].x * v0[j].x + v0[j].y * v0[j].y) + (v0[j].z * v0[j].z + v0[j].w * v0[j].w);
                                  s1 += (v1[j].x + v1[j].y) + (v1[j].z + v1[j].w); q1 += (v1[j].x * v1[j].x + v1[j].y * v1[j].y) + (v1[j].z * v1[j].z + v1[j].w * v1[j].w); }
#pragma unroll
    for (int o = 1; o < 64; o <<= 1) { s0 += shx(s0, o, lane); q0 += shx(q0, o, lane); s1 += shx(s1, o, lane); q1 += shx(q1, o, lane); }
    const float m0 = s0 * (1.f / DM), m1 = s1 * (1.f / DM);
    const float r0 = 1.0f / sqrtf(fmaxf(q0 * (1.f / DM) - m0 * m0, 0.f) + LN_EPS), r1 = 1.0f / sqrtf(fmaxf(q1 * (1.f / DM) - m1 * m1, 0.f) + LN_EPS);
#pragma unroll
    for (int j = 0; j < 4; ++j) { const f32x4 gg = ((const f32x4*)g)[64 * j + lane], bb = ((const f32x4*)b)[64 * j + lane]; v0[j] = (v0[j] - m0) * r0 * gg + bb; v1[j] = (v1[j] - m1) * r1 * gg + bb; }
}
template <int N> __device__ __forceinline__ float reduce_lanes(float (&a)[N], int lane) {
    int n = N, mask = 32;
#pragma unroll
    for (; n > 1; n >>= 1, mask >>= 1) {
        const bool up = (lane & mask) != 0;
#pragma unroll
        for (int i = 0; i < n / 2; ++i) { float lo = a[i], hi = a[i + n / 2]; asm volatile("" : "+v"(lo), "+v"(hi));
            const float mine = up ? hi : lo, oth = up ? lo : hi; a[i] = mine + shx(oth, mask, lane); }
    }
    float r = a[0];
#pragma unroll
    for (; mask >= 1; mask >>= 1) r += shx(r, mask, lane);
    return r;
}
struct RowA { const float* PRE; const float* lng; const float* lnb; const float* wr; const float* br; float* X1; bf16_t* X1B; unsigned* cnt; int* rowtok; float* rowgate; int* tokpos; };
__device__ __forceinline__ void phase_row_a(AT_LAS unsigned char* ldsb, const RowA& P, int G, int bx, const int tid) {
    float* part = (float*)(unsigned char*)ldsb;
    int* s_e = (int*)((unsigned char*)ldsb + MISC_OFF + 512);
    float* s_g = (float*)(s_e + 256);
    int* s_rank = (int*)(s_g + 256);
    int* s_cnt = s_rank + 256;
    int* s_base = s_cnt + 32;
    const int lane = tid & 63, wave = tid >> 6;
    if (tid < 32) s_cnt[tid] = 0;
    __syncthreads();
    for (int blk = bx; blk < NTOK / 64; blk += G) {
        const int t0 = blk * 64;
        f32x4 n0[4], n1[4];
#pragma unroll
        for (int j = 0; j < 4; ++j) { n0[j] = ((const f32x4*)(P.PRE + (size_t)(t0 + wave * 8) * DM))[64 * j + lane]; n1[j] = ((const f32x4*)(P.PRE + (size_t)(t0 + wave * 8 + 1) * DM))[64 * j + lane]; }
#pragma unroll 1
        for (int i = 0; i < 8; i += 2) {
            const int row = t0 + wave * 8 + i;
            f32x4 v0[4], v1[4];
#pragma unroll
            for (int j = 0; j < 4; ++j) { v0[j] = n0[j]; v1[j] = n1[j]; }
            if (i + 2 < 8) {
#pragma unroll
                for (int j = 0; j < 4; ++j) { n0[j] = ((const f32x4*)(P.PRE + (size_t)(row + 2) * DM))[64 * j + lane]; n1[j] = ((const f32x4*)(P.PRE + (size_t)(row + 3) * DM))[64 * j + lane]; } }
            ln_rows2(v0, v1, P.lng, P.lnb, lane);
#pragma unroll
            for (int j = 0; j < 4; ++j) { ((f32x4*)(P.X1 + (size_t)row * DM))[64 * j + lane] = v0[j]; ((f32x4*)(P.X1 + (size_t)(row + 1) * DM))[64 * j + lane] = v1[j];
                ((u32x2*)(P.X1B + (size_t)row * DM))[64 * j + lane] = (u32x2){pk2(v0[j].x, v0[j].y), pk2(v0[j].z, v0[j].w)};
                ((u32x2*)(P.X1B + (size_t)(row + 1) * DM))[64 * j + lane] = (u32x2){pk2(v1[j].x, v1[j].y), pk2(v1[j].z, v1[j].w)}; }
        }
        asm volatile("s_waitcnt vmcnt(0)" ::: "memory");
        __syncthreads();
        {
            const int tb = wave >> 2, ks = wave & 3, ti = lane & 31, kh = lane >> 5;
            const float* xr = P.X1 + (size_t)(t0 + 32 * tb + ti) * DM + ks * 256 + 4 * kh;
            const float* wr = P.wr + (size_t)(ks * 256 + 4 * kh) * NEXP + ti;
            at::f32x16 acc = {};
#pragma unroll 4
            for (int c = 0; c < 32; ++c) {
                const f32x4 xa = __builtin_nontemporal_load((const f32x4*)(xr + 8 * c));
                const float w0 = wr[(8 * c + 0) * NEXP], w1 = wr[(8 * c + 1) * NEXP], w2 = wr[(8 * c + 2) * NEXP], w3 = wr[(8 * c + 3) * NEXP];
                acc = __builtin_amdgcn_mfma_f32_32x32x2f32(xa.x, w0, acc, 0, 0, 0); acc = __builtin_amdgcn_mfma_f32_32x32x2f32(xa.y, w1, acc, 0, 0, 0);
                acc = __builtin_amdgcn_mfma_f32_32x32x2f32(xa.z, w2, acc, 0, 0, 0); acc = __builtin_amdgcn_mfma_f32_32x32x2f32(xa.w, w3, acc, 0, 0, 0);
            }
            float* pw = part + wave * (32 * 33);
#pragma unroll
            for (int r = 0; r < 16; ++r) pw[((r & 3) + 8 * (r >> 2) + 4 * kh) * 33 + ti] = acc[r];
        }
        __syncthreads();
        if (tid < 64) {
            const float* p0 = part + ((tid >> 5) * 4) * (32 * 33) + (tid & 31) * 33;
            float lv[NEXP];
#pragma unroll
            for (int e = 0; e < NEXP; ++e) lv[e] = ((p0[e] + p0[32 * 33 + e]) + (p0[2 * 32 * 33 + e] + p0[3 * 32 * 33 + e])) + P.br[e];
            float tv[4]; int ti4[4];
#pragma unroll
            for (int k = 0; k < 4; ++k) { float bv = lv[0]; int bi = 0;
#pragma unroll
                for (int e = 1; e < NEXP; ++e) if (lv[e] > bv) { bv = lv[e]; bi = e; }
                tv[k] = bv; ti4[k] = bi;
#pragma unroll
                for (int e = 0; e < NEXP; ++e) if (e == bi) lv[e] = -INFINITY; }
            const float e1 = __builtin_amdgcn_exp2f(LOG2E * (tv[1] - tv[0])), e2 = __builtin_amdgcn_exp2f(LOG2E * (tv[2] - tv[0])), e3 = __builtin_amdgcn_exp2f(LOG2E * (tv[3] - tv[0])); const float inv = 1.0f / (1.0f + e1 + e2 + e3);
            const int r4 = tid * 4; s_e[r4 + 0] = ti4[0]; s_e[r4 + 1] = ti4[1]; s_e[r4 + 2] = ti4[2]; s_e[r4 + 3] = ti4[3];
            s_g[r4 + 0] = inv; s_g[r4 + 1] = e1 * inv; s_g[r4 + 2] = e2 * inv; s_g[r4 + 3] = e3 * inv;
        }
        __syncthreads();
        if (tid < 256) s_rank[tid] = atomicAdd(&s_cnt[s_e[tid]], 1);
        __syncthreads();
        if (tid < 32) { const int c = s_cnt[tid]; s_base[tid] = c ? (int)atomicAdd(&P.cnt[tid], (unsigned)c) : 0; }
        __syncthreads();
        if (tid < 256) { const int e = s_e[tid], idx = s_base[e] + s_rank[tid], tok = t0 + (tid >> 2);
            P.rowtok[(size_t)e * ECAP + idx] = tok; P.rowgate[(size_t)e * ECAP + idx] = s_g[tid]; P.tokpos[tok * 4 + (tid & 3)] = e * ECAP + idx; }
        if (tid < 32) s_cnt[tid] = 0;
        __syncthreads();
    }
}
struct RowB { const float* X1; const bf16_t* YROWS; const int* tokpos; const unsigned* cnt; const float* lng; const float* lnb; float* X2; bf16_t* X2B; const float* wsh; const float* bfg; float* FLOG; };
template <int MODE> __device__ __forceinline__ void phase_row_b(AT_LAS unsigned char* ldsb, const RowB& P, int G, int bx, const int tid) {
    float* wT = (float*)(unsigned char*)ldsb;
    int* s_pst = (int*)((unsigned char*)ldsb + MISC_OFF);
    const int lane = tid & 63, wave = tid >> 6;
    if (MODE == 0) load_wT(wT, P.wsh, 1548, 1536, NFOX, tid);
    if (tid == 0) { int acc = 0; for (int e = 0; e < NEXP; ++e) { s_pst[e] = acc * 256; acc += ((int)P.cnt[e] + 255) / 256; } }
    float mybias = 0.f; if (MODE == 0) { const int h = lane >> 2; if (h < NFOX) mybias = P.bfg[h]; }
    __syncthreads();
    for (int row = bx * 8 + wave; row < NTOK; row += G * 8) {
        f32x4 v[4];
        const int4 tp4 = *(const int4*)(P.tokpos + row * 4);
        const int tps[4] = {tp4.x, tp4.y, tp4.z, tp4.w};
        u32x2 w[4][4];
#pragma unroll
        for (int k = 0; k < 4; ++k) { const int tp = tps[k]; const int e = tp >> 14, idx = tp & (ECAP - 1); const size_t yr = (size_t)(s_pst[e] + idx);
#pragma unroll
            for (int j = 0; j < 4; ++j) w[k][j] = ((const u32x2*)(P.YROWS + yr * DM))[64 * j + lane]; }
#pragma unroll
        for (int j = 0; j < 4; ++j) v[j] = ((const f32x4*)(P.X1 + (size_t)row * DM))[64 * j + lane] * DN_ALPHA;
#pragma unroll
        for (int k = 0; k < 4; ++k)
#pragma unroll
            for (int j = 0; j < 4; ++j) { v[j].x += __uint_as_float(w[k][j].x << 16); v[j].y += __uint_as_float(w[k][j].x & 0xffff0000u); v[j].z += __uint_as_float(w[k][j].y << 16); v[j].w += __uint_as_float(w[k][j].y & 0xffff0000u); }
        ln_rows(v, P.lng, P.lnb, lane);
#pragma unroll
        for (int j = 0; j < 4; ++j) ((f32x4*)(P.X2 + (size_t)row * DM))[64 * j + lane] = v[j];
        if (MODE == 0) {
#pragma unroll
            for (int j = 0; j < 4; ++j) ((u32x2*)(P.X2B + (size_t)row * DM))[64 * j + lane] = (u32x2){pk2(v[j].x, v[j].y), pk2(v[j].z, v[j].w)};
            float a[16];
#pragma unroll
            for (int e = 0; e < 16; ++e) { float x = 0.f;
                if (e < NFOX) {
#pragma unroll
                    for (int j = 0; j < 4; ++j) { const f32x4 ww = ((const f32x4*)(wT + e * DM))[64 * j + lane]; x += (v[j].x * ww.x + v[j].y * ww.y) + (v[j].z * ww.z + v[j].w * ww.w); } }
                a[e] = x; }
            const float z = reduce_lanes<16>(a, lane) + mybias;
            if ((lane & 3) == 0 && (lane >> 2) < NFOX) { const float ls = fminf(z, 0.f) - 0.6931471805599453f * __builtin_amdgcn_logf(1.0f + __builtin_amdgcn_exp2f(-LOG2E * fabsf(z)));
                const int b = row >> 11, t = row & (SEQ - 1); P.FLOG[(size_t)(b * NFOX + (lane >> 2)) * SEQ + t] = ls; }
        }
    }
}
__device__ __forceinline__ void phase_cumsum(AT_LAS unsigned char* ldsb, const float* FLOG, float* CUM, bf16_t* CKB, int G, int bx, const int tid) {
    float* wsum = (float*)((unsigned char*)ldsb + MISC_OFF + 4096);
    const int lane = tid & 63, wave = tid >> 6;
    for (int q = bx; q < NB * NFOX; q += G) {
        const size_t base = (size_t)q * SEQ;
        const f32x4 x = ((const f32x4*)(FLOG + base))[tid];
        const float a0 = x.x, a1 = a0 + x.y, a2 = a1 + x.z, a3 = a2 + x.w;
        float incl = a3;
#pragma unroll
        for (int o = 1; o < 64; o <<= 1) { const float y = __int_as_float(__builtin_amdgcn_ds_bpermute(((lane - o) & 63) << 2, __float_as_int(incl))); if (lane >= o) incl += y; }
        if (lane == 63) wsum[wave] = incl;
        __syncthreads();
        float off = 0.f; for (int w = 0; w < wave; ++w) off += wsum[w];
        const float ex = off + incl - a3;
        const f32x4 cv = (f32x4){(ex + a0) * LOG2E, (ex + a1) * LOG2E, (ex + a2) * LOG2E, (ex + a3) * LOG2E};
        ((f32x4*)(CUM + base))[tid] = cv;
#pragma unroll
        for (int i = 0; i < 4; ++i) { const float nc = -cv[i]; const unsigned hb = pk2(nc, 0.f) & 0xffffu; const float hf = __uint_as_float(hb << 16); const unsigned lb = pk2(nc - hf, 0.f) & 0xffffu;
            ((u32x4*)(CKB + (base + (size_t)tid * 4 + i) * 8))[0] = (u32x4){0x3F803F80u, hb | (lb << 16), 0u, 0u}; }
        __syncthreads();
    }
}

#define XB_TMO      128
#define XB_XCNT(j)  (256  + 64 * (j))
#define XB_XSUB(j)  (1280 + 64 * (j))
#define XB_XGEN(j)  (2304 + 64 * (j))
#define XB_TOP      3328
#define XB_TOPGEN   3392
#define XCD_BAR_WORDS 3456
#define XB_SPIN_CAP (1u << 18)
__device__ __forceinline__ unsigned xb_ld(unsigned* p)              { return __hip_atomic_load(p, __ATOMIC_RELAXED, __HIP_MEMORY_SCOPE_AGENT); }
__device__ __forceinline__ unsigned xb_add(unsigned* p, unsigned v) { return __hip_atomic_fetch_add(p, v, __ATOMIC_RELAXED, __HIP_MEMORY_SCOPE_AGENT); }
__device__ __forceinline__ unsigned xb_xcc_id() { return (unsigned)__builtin_amdgcn_s_getreg((3 << 11) | 20) & 0xFu; }
#define XB_SPIN(cond, bar) do { unsigned _sp = 0; while (cond) { __builtin_amdgcn_s_sleep(1); \
    if ((++_sp & 255u) == 0u) { if (xb_ld(&(bar)[XB_TMO])) break; if (_sp > XB_SPIN_CAP) { atomicAdd(&(bar)[XB_TMO], 1u); break; } } } } while (0)
struct XcdBarrier { unsigned* bar; unsigned x; volatile AT_LAS unsigned* st; };
__device__ __forceinline__ XcdBarrier xcd_barrier_post(unsigned* bar, volatile AT_LAS unsigned* st, int tid) {
    XcdBarrier b; b.bar = bar; b.x = xb_xcc_id(); b.st = st;
    if (tid == 0) (void)xb_add(&bar[XB_XCNT(b.x)], 1u);
    return b;
}
__device__ __forceinline__ void xcd_barrier_complete(unsigned* bar, unsigned x, unsigned& nloc, unsigned& nx) {
    const unsigned G = gridDim.x * gridDim.y * gridDim.z;
    unsigned sum, cnt, mine, sp = 0u;
    for (;;) {
        sum = 0u; cnt = 0u; mine = 0u;
#pragma unroll
        for (unsigned j = 0; j < 16; ++j) { const unsigned c = xb_ld(&bar[XB_XCNT(j)]); sum += c; cnt += (c > 0u) ? 1u : 0u; mine = (j == x) ? c : mine; }
        if (sum == G) break;
        __builtin_amdgcn_s_sleep(1);
        if ((++sp & 255u) == 0u) { if (xb_ld(&bar[XB_TMO])) break; if (sp > XB_SPIN_CAP) { atomicAdd(&bar[XB_TMO], 1u); break; } }
    }
    nloc = mine > 0u ? mine : 1u; nx = cnt > 0u ? cnt : 1u;
}
__device__ __forceinline__ void xcd_barrier(const XcdBarrier& b, int tid) {
    asm volatile("s_waitcnt vmcnt(0)" ::: "memory");
    __syncthreads();
    if (tid == 0) {
        unsigned* bar = b.bar; asm volatile("" : "+s"(bar));
        __builtin_amdgcn_s_waitcnt(0);
        unsigned nloc = b.st[0], nx = b.st[1];
        if (nloc == 0u) { xcd_barrier_complete(bar, b.x, nloc, nx); b.st[0] = nloc; b.st[1] = nx; }
        const unsigned old = xb_add(&bar[XB_XSUB(b.x)], 1u);
        const unsigned gen = old / nloc;
        if (old + 1u == (gen + 1u) * nloc) {
            __builtin_amdgcn_fence(__ATOMIC_RELEASE, "agent");
            asm volatile("s_waitcnt vmcnt(0)" ::: "memory");
            const unsigned og = xb_add(&bar[XB_TOP], 1u);
            const unsigned tg = og / nx;
            if (og + 1u == (tg + 1u) * nx) xb_add(&bar[XB_TOPGEN], 1u);
            else XB_SPIN(xb_ld(&bar[XB_TOPGEN]) == tg, bar);
            __builtin_amdgcn_fence(__ATOMIC_ACQUIRE, "agent");
            xb_add(&bar[XB_XGEN(b.x)], 1u);
            asm volatile("s_waitcnt vmcnt(0)" ::: "memory");
        } else {
            XB_SPIN(xb_ld(&bar[XB_XGEN(b.x)]) == gen, bar);
            __builtin_amdgcn_fence(__ATOMIC_ACQUIRE, "agent");
            asm volatile("s_waitcnt vmcnt(0)" ::: "memory");
        }
    }
    __syncthreads();
}

struct TrJob { const float* W; int ldw, K, Np; bf16_t* WT; int nmat; size_t sstride, dstride; };
template <int MAP> __device__ __forceinline__ void tr_job(const TrJob& j, float* scr, int gw, int NGW, int lane) {
    const int nblk = j.Np / 32, per = (j.K / 64) * nblk; const long total = (long)per * j.nmat;
    for (long it = gw; it < total; it += NGW) { const int mat = (int)(it / per), item = (int)(it % per);
        transpose_item<MAP>(j.W + mat * j.sstride, j.ldw, 0, j.K, j.WT + mat * j.dstride, item, nblk, scr, lane); }
}
__device__ __forceinline__ void cvt_rows(const float* src, bf16_t* dst, size_t n8, size_t gt, size_t NGT) {
    for (size_t i = gt; i < n8; i += NGT) { const f32x4 a = ((const f32x4*)src)[2 * i], b = ((const f32x4*)src)[2 * i + 1];
        u32x4 o; o.x = pk2(a.x, a.y); o.y = pk2(a.z, a.w); o.z = pk2(b.x, b.y); o.w = pk2(b.z, b.w); ((u32x4*)dst)[i] = o; }
}

constexpr unsigned STEAL_D0 = 32u * 512u, STEAL_GU = STEAL_D0 + 32u * 1024u, STEAL_TOTAL = STEAL_GU + 32u * 512u;
constexpr int CW_QNEXT = 512, CW_DONE = 576;
__device__ __forceinline__ void steal_convert(AT_LAS unsigned char* lds, unsigned char* lds_gen, const float* w_gu, const float* w_dn, bf16_t* WT_GU, bf16_t* WT_DN, unsigned* qnext, unsigned* done, unsigned limit, int G, int tid) {
    const int lane = tid & 63, wave = __builtin_amdgcn_readfirstlane(tid >> 6);
    float* scr = (float*)lds_gen + wave * 64 * 33;
    volatile AT_LAS unsigned* slot = (volatile AT_LAS unsigned*)(lds + MISC_OFF + 384);
    __syncthreads();
    if (done && tid == 0) __hip_atomic_fetch_add(done, 1u, __ATOMIC_RELAXED, __HIP_MEMORY_SCOPE_AGENT);
    for (;;) {
        if (tid == 0) { unsigned it = 0xFFFFFFFFu;
            const bool alldone = !done || __hip_atomic_load(done, __ATOMIC_RELAXED, __HIP_MEMORY_SCOPE_AGENT) >= (unsigned)G;
            const bool stop = alldone && __hip_atomic_load(qnext, __ATOMIC_RELAXED, __HIP_MEMORY_SCOPE_AGENT) >= limit;
            if (!stop) it = __hip_atomic_fetch_add(qnext, 8u, __ATOMIC_RELAXED, __HIP_MEMORY_SCOPE_AGENT);
            *slot = it; }
        __syncthreads();
        const unsigned it0 = *slot;
        __syncthreads();
        if (it0 >= STEAL_TOTAL) break;
        const unsigned it = it0 + (unsigned)wave;
        if (it < STEAL_D0) { const int mat = (int)(it >> 9), item = (int)(it & 511);
            transpose_item<0>(w_dn + (size_t)mat * DFF * DM, DM, 0, DFF, WT_DN + (size_t)mat * DM * DFF, item, 32, scr, lane); }
        else if (it < STEAL_GU) { const unsigned r = it - STEAL_D0; const int mat = (int)(r >> 10), item = (int)(r & 1023);
            transpose_item<2>(w_gu + (size_t)(32 + mat) * DM * 2048, 2048, 0, DM, WT_GU + (size_t)(32 + mat) * 2048 * DM, item, 64, scr, lane); }
        else if (it < STEAL_TOTAL) { const unsigned r = it - STEAL_GU; const int mat = (int)(r >> 9), item = (int)(r & 511);
            transpose_item<0>(w_dn + (size_t)(32 + mat) * DFF * DM, DM, 0, DFF, WT_DN + (size_t)(32 + mat) * DM * DFF, item, 32, scr, lane); }
    }
}

constexpr int CW_BAR = 4096;
constexpr int NPHASE = 15;
#ifndef PROBE_MASK
#define PROBE_MASK 0
#endif
struct MegaArgs { const float* in[19]; float* out; unsigned char* ws; int ph_lo, ph_hi; };
__device__ __forceinline__ int lane_id_volatile() { int l; asm volatile("v_mbcnt_lo_u32_b32 %0, -1, 0\n\tv_mbcnt_hi_u32_b32 %0, -1, %0" : "=v"(l)); return l; }
#define OPQ_S(x) asm volatile("" : "+s"(x))
#define OPQ_V(x) asm volatile("" : "+v"(x))
__global__ void __launch_bounds__(512, 2) k_mega(MegaArgs a) {
    extern __shared__ __attribute__((aligned(16))) unsigned char lds_raw[];
    AT_LAS unsigned char* lds = (AT_LAS unsigned char*)lds_raw;
    { const int t0 = threadIdx.x; for (int u = t0; u < (FAST_LDS - MISC_OFF) / 4; u += 512) ((AT_LAS unsigned*)(lds + MISC_OFF))[u] = 0u; }
    __syncthreads();
    const int lo = a.ph_lo, hi = a.ph_hi;
    const int wave_s = __builtin_amdgcn_readfirstlane(threadIdx.x >> 6);
    XcdBarrier bar; bar.bar = (unsigned*)(a.ws + WS_CTL) + CW_BAR; bar.x = 0; bar.st = (volatile AT_LAS unsigned*)(lds + MISC_OFF + 256);
    if (hi - lo > 1) bar = xcd_barrier_post((unsigned*)(a.ws + WS_CTL) + CW_BAR, (volatile AT_LAS unsigned*)(lds + MISC_OFF + 256), threadIdx.x);
#define PH_ENTER \
        int tid = wave_s * 64 + lane_id_volatile(); OPQ_V(tid); const __attribute__((address_space(4))) MegaArgs* ap = (const __attribute__((address_space(4))) MegaArgs*)__builtin_amdgcn_kernarg_segment_ptr(); OPQ_S(ap); unsigned char* ws = ap->ws; int G = gridDim.x, bx = blockIdx.x; OPQ_S(G); OPQ_S(bx); const int vcu = vcu_of(bx, G); (void)vcu; \
        const int l = (ph >= 8) ? 1 : 0; unsigned* cnt = (unsigned*)(ws + WS_CTL) + CW_CNT + l * 64; (void)cnt; AT_LAS int* pre = (AT_LAS int*)(lds + MISC_OFF); (void)pre;
#define P_BF(off) ((bf16_t*)(ws + (off)))
#define P_F32(off) ((float*)(ws + (off)))
#define STEAL(k, lim) steal_convert(lds, lds_raw, ap->in[15], ap->in[17], P_BF(WS_WT_GU), P_BF(WS_WT_DN), (unsigned*)(ws + WS_CTL) + CW_QNEXT, (k) < 0 ? nullptr : (unsigned*)(ws + WS_CTL) + CW_DONE + 64 * (k), (lim), G, tid)
#pragma unroll 1
    for (int r0 = 0; r0 < ((lo == 0) ? 1 + (PROBE_MASK & 1) : 0); ++r0) { const int ph = 0; PH_ENTER
            const int lane = tid & 63, wave = __builtin_amdgcn_readfirstlane(tid >> 6);
            float* scr = (float*)lds_raw + wave * 64 * 33;
            const int gw = vcu * 8 + wave, NGW = G * 8;
#define GW_AT(off) ((gw + NGW - ((off) % NGW)) % NGW)
            tr_job<1>(TrJob{ap->in[2], A_IN, DM, A_IN, P_BF(WS_WT_INA), 1, 0, 0}, scr, GW_AT(0), NGW, lane);
            tr_job<0>(TrJob{ap->in[6], 1548, DM, 1536, P_BF(WS_WT_INB), 1, 0, 0}, scr, GW_AT(1280), NGW, lane);
            tr_job<0>(TrJob{ap->in[4], 1024, DM, 1024, P_BF(WS_WT_INB) + (size_t)1536 * DM, 1, 0, 0}, scr, GW_AT(2048), NGW, lane);
            tr_job<0>(TrJob{ap->in[3], DM, A_OUT, DM, P_BF(WS_WT_OUTA), 1, 0, 0}, scr, GW_AT(2560), NGW, lane);
            tr_job<0>(TrJob{ap->in[5], DM, B_OUT, DM, P_BF(WS_WT_OUTB), 1, 0, 0}, scr, GW_AT(2816), NGW, lane);
            tr_job<0>(TrJob{ap->in[8], 512, DM, 512, P_BF(WS_WT_MKV), 2, (size_t)DM * 512, (size_t)512 * DM}, scr, GW_AT(3328), NGW, lane);
            tr_job<2>(TrJob{ap->in[15], 2048, DM, 2048, P_BF(WS_WT_GU), 32, (size_t)DM * 2048, (size_t)2048 * DM}, scr, GW_AT(3840), NGW, lane);
#undef GW_AT
            const size_t gt = (size_t)vcu * 512 + tid, NGT = (size_t)G * 512;
            cvt_rows(ap->in[0], P_BF(WS_XB), (size_t)NTOK * DM / 8, gt, NGT);
            cvt_rows(ap->in[1], P_BF(WS_MEMB), (size_t)NMEMROW * DM / 8, gt, NGT);
        if (hi > 1) xcd_barrier(bar, tid);
    }
#pragma unroll 1
    for (int pp = 2 * (lo < 1 ? 1 : lo); pp < 2 * hi; ++pp) {
        const int ph = pp >> 1;
        if ((pp & 1) && !((PROBE_MASK >> ph) & 1)) continue;
        switch (ph) {
        case 1: { PH_ENTER
            const bf16_t* WT_MKV = P_BF(WS_WT_MKV); const bf16_t* MEMB = P_BF(WS_MEMB); bf16_t* MEMKV = P_BF(WS_MEMKV);
            { fg::DenseSched S; S.init(P_BF(WS_WT_INA), NTOK, A_IN, DM, G, bx); fg::gemm_phase<0>(lds, P_BF(WS_XB), DM, S, EpiInA{P_BF(WS_QKV)}, tid); }
            { fg::DenseSched S; S.init(WT_MKV, NMEMROW, 512, DM, G, (bx + G / 2) % G); fg::gemm_phase<0>(lds, MEMB, DM, S, EpiPlain{MEMKV, 512, 0}, tid); }
            { fg::DenseSched S; S.init(WT_MKV + (size_t)512 * DM, NMEMROW, 512, DM, G, (bx + G / 2 + G - 16) % G); fg::gemm_phase<0>(lds, MEMB, DM, S, EpiPlain{MEMKV + (size_t)NMEMROW * 512, 512, 0}, tid); }
            STEAL(0, 0u);
        } break;
        case 2: { PH_ENTER phase_attn_a((AT_LAS char*)lds, P_BF(WS_QKV), P_BF(WS_MEMKV), P_BF(WS_MERGED), G, vcu, tid); } break;
        case 3: { PH_ENTER fg::DenseSched S; S.init(P_BF(WS_WT_OUTA), NTOK, DM, A_OUT, G, bx); fg::gemm_phase<0>(lds, P_BF(WS_MERGED), A_OUT, S, EpiOut{P_F32(WS_PRE), ap->in[0]}, tid); } break;
        case 4: case 11: { PH_ENTER
            if (l == 1) STEAL(-1, STEAL_GU);
            phase_row_a(lds, RowA{P_F32(WS_PRE), ap->in[9] + l * DM, ap->in[10] + l * DM, ap->in[13] + (size_t)l * DM * NEXP, ap->in[14] + l * NEXP, P_F32(WS_X1), P_BF(WS_X1B), cnt,
                                  (int*)(ws + WS_ROWTOK), P_F32(WS_ROWGATE), (int*)(ws + WS_TOKPOS)}, G, bx, tid); } break;
        case 5: case 12: { PH_ENTER fg::moe_prefix(cnt, pre, 8, tid); fg::MoeSched<1> S{P_BF(WS_WT_GU) + (size_t)l * 32 * 2048 * DM, cnt, (const int*)(ws + WS_ROWTOK), pre, G, vcu};
            fg::gemm_phase<1>(lds, P_BF(WS_X1B), DM, S, EpiGU{P_BF(WS_ACT), ap->in[16] + (size_t)l * 32 * 2048}, tid);
            if (l == 0) STEAL(1, STEAL_D0); else STEAL(4, STEAL_TOTAL); } break;
        case 6: case 13: { PH_ENTER fg::moe_prefix(cnt, pre, 4, tid); fg::MoeSched<0> S{P_BF(WS_WT_DN) + (size_t)l * 32 * DM * DFF, cnt, nullptr, pre, G, vcu};
            fg::gemm_phase<0>(lds, P_BF(WS_ACT), DFF, S, EpiDN{P_BF(WS_YROWS), ap->in[18] + (size_t)l * 32 * DM, P_F32(WS_ROWGATE)}, tid); if (l == 0) STEAL(2, 0u); } break;
        case 7: { PH_ENTER phase_row_b<0>(lds, RowB{P_F32(WS_X1), P_BF(WS_YROWS), (const int*)(ws + WS_TOKPOS), cnt, ap->in[11], ap->in[12], P_F32(WS_X2), P_BF(WS_XB), ap->in[6], ap->in[7], P_F32(WS_FLOG)}, G, bx, tid); } break;
        case 8: { PH_ENTER phase_cumsum(lds, P_F32(WS_FLOG), P_F32(WS_CUM), P_BF(WS_CKB), G, (bx + G / 2) % G, tid);
            fg::DenseSched S; S.init(P_BF(WS_WT_INB), NTOK, B_IN, DM, G, bx); fg::gemm_phase<0>(lds, P_BF(WS_XB), DM, S, EpiInB{P_BF(WS_QKV)}, tid); STEAL(3, 0u); } break;
        case 9: { PH_ENTER phase_attn_b((AT_LAS char*)lds, P_BF(WS_QKV), P_F32(WS_CUM), P_BF(WS_CKB), P_BF(WS_MEMKV) + (size_t)NMEMROW * 512, P_BF(WS_MERGED), G, vcu, tid); } break;
        case 10: { PH_ENTER fg::DenseSched S; S.init(P_BF(WS_WT_OUTB), NTOK, DM, B_OUT, G, bx); fg::gemm_phase<0>(lds, P_BF(WS_MERGED), B_OUT, S, EpiOut{P_F32(WS_PRE), P_F32(WS_X2)}, tid); } break;
        case 14: { PH_ENTER phase_row_b<1>(lds, RowB{P_F32(WS_X1), P_BF(WS_YROWS), (const int*)(ws + WS_TOKPOS), cnt, ap->in[11] + DM, ap->in[12] + DM, ap->out, nullptr, nullptr, nullptr, nullptr}, G, bx, tid); } break;
        default: break;
        }
#undef PH_ENTER
        if (pp + 1 < 2 * hi) { int tb = wave_s * 64 + lane_id_volatile(); OPQ_V(tb); xcd_barrier(bar, tb);
#if defined(PROBE_BAR)
            xcd_barrier(bar, tb);
#endif
        }
    }
}

#ifndef N_LAUNCHES
#define N_LAUNCHES 1
#endif
extern "C" void kernel_launch(void* const* d_in, const int* in_sizes, int n_in, void* d_out, int out_size, void* d_ws, size_t ws_size, hipStream_t stream) {
    static int grid = 0;
    if (grid == 0) {
        if (n_in != 19 || out_size != NTOK * DM || ws_size < WS_END) { fprintf(stderr, "kernel_launch: unexpected shapes (n_in %d out %d ws %zu)\n", n_in, out_size, ws_size); grid = -1; return; }
        int dev = 0, cus = 0;
        if (hipGetDevice(&dev) != hipSuccess || hipDeviceGetAttribute(&cus, hipDeviceAttributeMultiprocessorCount, dev) != hipSuccess || cus <= 0) { fprintf(stderr, "kernel_launch: device query failed\n"); grid = -1; return; }
        if (hipFuncSetAttribute((const void*)k_mega, hipFuncAttributeMaxDynamicSharedMemorySize, FAST_LDS) != hipSuccess) { fprintf(stderr, "kernel_launch: hipFuncSetAttribute failed\n"); grid = -1; return; }
        grid = cus;
    }
    if (grid < 0) return;
    (void)hipMemsetAsync((char*)d_ws + WS_CTL, 0, 1 * MiB, stream);
    MegaArgs a{};
    for (int i = 0; i < 19; ++i) a.in[i] = (const float*)d_in[i];
    a.out = (float*)d_out; a.ws = (unsigned char*)d_ws;
    if (N_LAUNCHES == 1) { a.ph_lo = 0; a.ph_hi = NPHASE; hipLaunchKernelGGL(k_mega, dim3(grid), dim3(512), FAST_LDS, stream, a); }
    else for (int p = 0; p < NPHASE; ++p) { a.ph_lo = p; a.ph_hi = p + 1; hipLaunchKernelGGL(k_mega, dim3(grid), dim3(512), FAST_LDS, stream, a); }
}
```

```cpp
#include <hip/hip_runtime.h>
#include <cstdio>
#include <cstdint>

typedef unsigned short bf16_t;
typedef float f32x4 __attribute__((ext_vector_type(4)));
typedef float f32x2 __attribute__((ext_vector_type(2)));
typedef unsigned u32x4 __attribute__((ext_vector_type(4)));
typedef unsigned u32x2 __attribute__((ext_vector_type(2)));

constexpr int DM = 1024, NB = 8, SEQ = 2048, NTOK = NB * SEQ, HD = 64;
constexpr int MEM_LEN = 256, NMEMROW = NB * MEM_LEN;
constexpr int A_IN = 2560, A_OUT = 512, B_IN = 2560  , B_OUT = 1024;
constexpr int NEXP = 32, TOPK = 4, DFF = 1024, ECAP = NTOK;
constexpr int NFOX = 12;
constexpr int MAXROWS = 73728;
constexpr size_t LA_K = (size_t)3 * 8 * 4 * 2048 * 64, LA_QM = 3 * LA_K;
constexpr size_t LB_V = (size_t)768 * 16384, LB_QF = 2 * LB_V, LB_QM = 3 * LB_V;
constexpr float LN_EPS = 1e-5f;
constexpr float DN_ALPHA = 1.4142135623730951f;
constexpr float C2 = 0.125f * 1.4426950408889634f;
constexpr float LOG2E = 1.4426950408889634f;
constexpr float SW_LIMIT = 7.0f, SW_ALPHA = 1.702f;

constexpr size_t MiB = 1ull << 20;
constexpr size_t WS_CTL = 0;
constexpr size_t WS_ROPE = 1 * MiB;
constexpr size_t WS_CUM = 2 * MiB;
constexpr size_t WS_FLOG = 3 * MiB;
constexpr size_t WS_ROWTOK = 4 * MiB;
constexpr size_t WS_ROWGATE = 6 * MiB;
constexpr size_t WS_TOKPOS = 8 * MiB;
constexpr size_t WS_MEMB = 10 * MiB;
constexpr size_t WS_MEMKV = 14 * MiB;
constexpr size_t WS_WT_INA = 18 * MiB;
constexpr size_t WS_WT_INB = 23 * MiB;
constexpr size_t WS_WT_OUTA = 28 * MiB;
constexpr size_t WS_WT_OUTB = 29 * MiB;
constexpr size_t WS_WT_MKV = 31 * MiB;
constexpr size_t WS_XB = 34 * MiB;
constexpr size_t WS_X1B = 66 * MiB;
constexpr size_t WS_QKV = 98 * MiB;
constexpr size_t WS_MERGED = 178 * MiB;
constexpr size_t WS_PRE = 210 * MiB;
constexpr size_t WS_X1 = 274 * MiB;
constexpr size_t WS_X2 = 338 * MiB;
constexpr size_t WS_ACT = 402 * MiB;
constexpr size_t WS_YROWS = 546 * MiB;
constexpr size_t WS_WT_GU = 690 * MiB;
constexpr size_t WS_WT_DN = 946 * MiB;
constexpr size_t WS_CKB = 1074 * MiB;
constexpr size_t WS_END = 1078 * MiB;
constexpr int CW_CNT = 64;

__device__ __forceinline__ float bf2f(bf16_t v) { return __uint_as_float((unsigned)v << 16); }
__device__ __forceinline__ unsigned f2bf(float f) { unsigned u = __float_as_uint(f); return (u + 0x7fffu + ((u >> 16) & 1u)) >> 16; }
typedef __bf16 hwbf16x2_t __attribute__((ext_vector_type(2)));
__device__ __forceinline__ unsigned pk2(float lo, float hi) { f32x2 v = {lo, hi}; hwbf16x2_t b = __builtin_convertvector(v, hwbf16x2_t); return __builtin_bit_cast(unsigned, b); }
__device__ __forceinline__ void unpack8(const u32x4 w, float* f) {
    f[0] = __uint_as_float(w.x << 16); f[1] = __uint_as_float(w.x & 0xffff0000u);
    f[2] = __uint_as_float(w.y << 16); f[3] = __uint_as_float(w.y & 0xffff0000u);
    f[4] = __uint_as_float(w.z << 16); f[5] = __uint_as_float(w.z & 0xffff0000u);
    f[6] = __uint_as_float(w.w << 16); f[7] = __uint_as_float(w.w & 0xffff0000u);
}
__device__ __forceinline__ float shx(float v, int mask, int lane) { return __int_as_float(__builtin_amdgcn_ds_bpermute((lane ^ mask) << 2, __float_as_int(v))); }

__constant__ double c_invfreq[32] = {1.0, 0.7498942093324559, 0.5623413251903491, 0.4216965034285822, 0.31622776601683794, 0.23713737056616552, 0.1778279410038923, 0.1333521432163324, 0.1, 0.07498942093324558, 0.05623413251903491, 0.042169650342858224, 0.03162277660168379, 0.023713737056616554, 0.01778279410038923, 0.01333521432163324, 0.01, 0.007498942093324558, 0.005623413251903491, 0.004216965034285823, 0.0031622776601683794, 0.0023713737056616554, 0.0017782794100389228, 0.001333521432163324, 0.001, 0.0007498942093324559, 0.0005623413251903491, 0.00042169650342858224, 0.00031622776601683794, 0.00023713737056616554, 0.00017782794100389227, 0.0001333521432163324};

__device__ __forceinline__ void sincos_d(double a, float& s, float& c) {
    const double n = rint(a * 0.15915494309189535);
    double r = fma(-n, 6.283185307179586, a);
    r = fma(-n, 2.4492935982947064e-16, r);
    const double h = 0.5 * r, h2 = h * h;
    double sp = 1.0 / 355687428096000.0;
    sp = fma(sp, h2, -1.0 / 1307674368000.0); sp = fma(sp, h2, 1.0 / 6227020800.0); sp = fma(sp, h2, -1.0 / 39916800.0);
    sp = fma(sp, h2, 1.0 / 362880.0); sp = fma(sp, h2, -1.0 / 5040.0); sp = fma(sp, h2, 1.0 / 120.0); sp = fma(sp, h2, -1.0 / 6.0); sp = fma(sp, h2, 1.0);
    const double sh = sp * h;
    double cp = 1.0 / 20922789888000.0;
    cp = fma(cp, h2, -1.0 / 87178291200.0); cp = fma(cp, h2, 1.0 / 479001600.0); cp = fma(cp, h2, -1.0 / 3628800.0);
    cp = fma(cp, h2, 1.0 / 40320.0); cp = fma(cp, h2, -1.0 / 720.0); cp = fma(cp, h2, 1.0 / 24.0); cp = fma(cp, h2, -0.5); cp = fma(cp, h2, 1.0);
    s = (float)(2.0 * sh * cp); c = (float)(1.0 - 2.0 * sh * sh);
}

template <int MAP> __device__ __forceinline__ int colmap(int p) {
    if (MAP == 1) {
        if (p >= 2304) return p;
        const int rem = p % 768, part = rem >> 8;
        if (part == 2) return p;
        const int dd = p & 63, d = (dd & 1) ? (dd >> 1) + 32 : (dd >> 1);
        return (p & ~63) + d;
    } else if (MAP == 2) {
        return ((p & 255) >> 7) * 1024 + (p >> 8) * 128 + (p & 127);
    }
    return p;
}
template <int MAP> __device__ __forceinline__ void transpose_item(const float* __restrict__ W, int ldw, int coloff, int K, bf16_t* __restrict__ WT, int item, int nblk, float* scr, int lane) {
    const int kb = item / nblk, nb = item % nblk, k0 = 64 * kb, n0 = 32 * nb;
    if (MAP == 1) {
        const int srcc = coloff + colmap<MAP>(n0 + (lane & 31));
#pragma unroll 8
        for (int i = 0; i < 32; ++i) { const int kk = 2 * i + (lane >> 5); scr[kk * 33 + (lane & 31)] = W[(size_t)(k0 + kk) * ldw + srcc]; }
    } else {
        const int c4 = (lane & 7) * 4, srcc = coloff + colmap<MAP>(n0 + c4);
        f32x4 v[8];
#pragma unroll
        for (int i = 0; i < 8; ++i) v[i] = __builtin_nontemporal_load((const f32x4*)(W + (size_t)(k0 + 8 * i + (lane >> 3)) * ldw + srcc));
#pragma unroll
        for (int i = 0; i < 8; ++i) { float* d = scr + (8 * i + (lane >> 3)) * 33 + c4; d[0] = v[i].x; d[1] = v[i].y; d[2] = v[i].z; d[3] = v[i].w; }
    }
    asm volatile("s_waitcnt lgkmcnt(0)" ::: "memory");
    const int c = lane & 7;
#pragma unroll
    for (int j = 0; j < 4; ++j) { const int n = (lane >> 3) + 8 * j; const float* s = scr + (8 * c) * 33 + n;
        u32x4 o; o.x = pk2(s[0 * 33], s[1 * 33]); o.y = pk2(s[2 * 33], s[3 * 33]); o.z = pk2(s[4 * 33], s[5 * 33]); o.w = pk2(s[6 * 33], s[7 * 33]);
        __builtin_nontemporal_store(o, (u32x4*)(WT + (size_t)(n0 + n) * K + k0 + 8 * c)); }
    asm volatile("s_waitcnt lgkmcnt(0)" ::: "memory");
}
#define EPI_ROW(ai, m) ((ai) * 128 + wr * 64 + (m) * 16 + fr)
#define EPI_COL(bj, n) ((bj) * 128 + wc * 32 + (n) * 16 + 4 * fq)
#define EPI_COLP(bj) ((bj) * 128 + wc * 32 + 8 * fq)
__device__ __forceinline__ u32x4 pk8(const f32x4 a, const f32x4 b) { return (u32x4){pk2(a.x, a.y), pk2(a.z, a.w), pk2(b.x, b.y), pk2(b.z, b.w)}; }
#define EPI_XROW (lane_ >> 2)
#define EPI_XCOL (8 * (lane_ & 3))
__device__ __forceinline__ u32x4 epi_xpose(__attribute__((address_space(3))) unsigned char* xb, const u32x4 v, int fr, int fq, int lane_) {
    *(__attribute__((address_space(3))) u32x4*)(xb + fr * 80 + fq * 16) = v;
    return *(const __attribute__((address_space(3))) u32x4*)(xb + (lane_ >> 2) * 80 + (lane_ & 3) * 16);
}
struct EpiInA { bf16_t* out;
    static constexpr bool PERM = true;
    template <class U> __device__ __forceinline__ void tile(const U& u, const f32x4 (&acc)[2][2][4][2], int wr, int wc, int fr, int fq, __attribute__((address_space(3))) unsigned char* xb) const {
        const int lane_ = fq * 16 + fr; (void)lane_;
#pragma unroll
        for (int bj = 0; bj < 2; ++bj) {
            const int p = u.col0 + EPI_COLP(bj); const int part = (p < 2304) ? ((p % 768) >> 8) : 3;
            const int j0 = (p & 63) >> 1; float f[4];
#pragma unroll
            for (int i = 0; i < 4; ++i) f[i] = __builtin_amdgcn_exp2f(-(float)(j0 + i) * 0.41524101186092034f) * 0.15915494309189535f;
#pragma unroll
            for (int ai = 0; ai < 2; ++ai)
#pragma unroll
                for (int m = 0; m < 4; ++m) { const int row = u.row0 + EPI_ROW(ai, m); f32x4 v[2] = {acc[ai][bj][m][0], acc[ai][bj][m][1]};
                    if (part < 2) { const float pos = (float)(row & (SEQ - 1));
#pragma unroll
                        for (int n = 0; n < 2; ++n) { const float t0 = __builtin_amdgcn_fractf(pos * f[2 * n]), t1 = __builtin_amdgcn_fractf(pos * f[2 * n + 1]);
                            const float c0 = __builtin_amdgcn_cosf(t0), s0 = __builtin_amdgcn_sinf(t0), c1 = __builtin_amdgcn_cosf(t1), s1 = __builtin_amdgcn_sinf(t1);
                            f32x4 o; o.x = v[n].x * c0 - v[n].y * s0; o.y = v[n].y * c0 + v[n].x * s0; o.z = v[n].z * c1 - v[n].w * s1; o.w = v[n].w * c1 + v[n].z * s1; v[n] = o; } }
                    if (part == 0 || part == 3) { v[0] = v[0] * C2; v[1] = v[1] * C2; }
                    const u32x4 vx = epi_xpose(xb, pk8(v[0], v[1]), fr, fq, lane_);
                    const int px = u.col0 + bj * 128 + wc * 32 + EPI_XCOL, rowx = row - fr + EPI_XROW;
                    const int bb = rowx >> 11, t = rowx & (SEQ - 1); size_t off;
                    if (part == 3) off = LA_QM + ((size_t)((bb * 4 + ((px - 2304) >> 6)) * SEQ + t) << 6) + (px & 63);
                    else { const int g = px / 768, hh = ((px - g * 768) >> 6) & 3, dsh = 2 * g, gb = (g * 8 + bb) * 4 + hh;
                        if (part == 0) off = ((size_t)((gb * 16 + (t & 15)) * 128 + (t >> 4)) << 6) + (px & 63);
                        else off = LA_K * part + ((size_t)(gb * SEQ + (t & ((1 << dsh) - 1)) * (SEQ >> dsh) + (t >> dsh)) << 6) + (px & 63); }
                    *(u32x4*)(out + off) = vx; }
        }
    } };
struct EpiInB { bf16_t* out;
    static constexpr bool PERM = true;
    template <class U> __device__ __forceinline__ void tile(const U& u, const f32x4 (&acc)[2][2][4][2], int wr, int wc, int fr, int fq, __attribute__((address_space(3))) unsigned char* xb) const {
        const int lane_ = fq * 16 + fr; (void)lane_;
#pragma unroll
        for (int ai = 0; ai < 2; ++ai)
#pragma unroll
            for (int m = 0; m < 4; ++m) { const int row = u.row0 + EPI_ROW(ai, m);
#pragma unroll
                for (int bj = 0; bj < 2; ++bj) { const int p0 = u.col0 + EPI_COLP(bj); const float sc = (p0 >= 1536) ? C2 : 1.0f;
                    const u32x4 v = epi_xpose(xb, pk8(acc[ai][bj][m][0] * sc, acc[ai][bj][m][1] * sc), fr, fq, lane_);
                    const int p = u.col0 + bj * 128 + wc * 32 + EPI_XCOL, rowx = row - fr + EPI_XROW;
                    const int reg = p >= 2304 ? 3 : p / 768, pc = p - reg * 768, nh = reg == 3 ? 4 : NFOX, bb = rowx >> 11, t = rowx & (SEQ - 1);
                    *(u32x4*)(out + (size_t)reg * LB_V + ((size_t)((bb * nh + (pc >> 6)) * SEQ + t) << 6) + (pc & 63)) = v; } }
    } };
struct EpiPlain { bf16_t* out; int ld; int pad;
    static constexpr bool PERM = true;
    template <class U> __device__ __forceinline__ void tile(const U& u, const f32x4 (&acc)[2][2][4][2], int wr, int wc, int fr, int fq, __attribute__((address_space(3))) unsigned char* xb) const {
        const int lane_ = fq * 16 + fr; (void)lane_;
#pragma unroll
        for (int ai = 0; ai < 2; ++ai)
#pragma unroll
            for (int m = 0; m < 4; ++m) { const int row = u.row0 + EPI_ROW(ai, m);
#pragma unroll
                for (int bj = 0; bj < 2; ++bj) *(u32x4*)(out + (size_t)(row - fr + EPI_XROW) * ld + u.col0 + bj * 128 + wc * 32 + EPI_XCOL) = epi_xpose(xb, pk8(acc[ai][bj][m][0], acc[ai][bj][m][1]), fr, fq, lane_); }
    } };
struct EpiOut { float* pre; const float* res;
    static constexpr bool PERM = false;
    template <class U> __device__ __forceinline__ void tile(const U& u, const f32x4 (&acc)[2][2][4][2], int wr, int wc, int fr, int fq, __attribute__((address_space(3))) unsigned char* xb) const {
        const int lane_ = fq * 16 + fr; (void)lane_;
#pragma unroll
        for (int ai = 0; ai < 2; ++ai) {
            f32x4 x[4][2][2];
#pragma unroll
            for (int m = 0; m < 4; ++m)
#pragma unroll
                for (int bj = 0; bj < 2; ++bj)
#pragma unroll
                    for (int n = 0; n < 2; ++n) x[m][bj][n] = *(const f32x4*)(res + (size_t)(u.row0 + ai * 128 + wr * 64 + m * 16 + EPI_XROW) * DM + u.col0 + bj * 128 + wc * 32 + n * 16 + 4 * (lane_ & 3));
#pragma unroll
            for (int m = 0; m < 4; ++m)
#pragma unroll
                for (int bj = 0; bj < 2; ++bj)
#pragma unroll
                    for (int n = 0; n < 2; ++n) { const f32x4 at = __builtin_bit_cast(f32x4, epi_xpose(xb, __builtin_bit_cast(u32x4, acc[ai][bj][m][n]), fr, fq, lane_));
                        *(f32x4*)(pre + (size_t)(u.row0 + ai * 128 + wr * 64 + m * 16 + EPI_XROW) * DM + u.col0 + bj * 128 + wc * 32 + n * 16 + 4 * (lane_ & 3)) = x[m][bj][n] * DN_ALPHA + at; }
        }
    } };
struct EpiGU { bf16_t* act; const float* bgu;
    static constexpr bool PERM = true;
    template <class U> __device__ __forceinline__ void tile(const U& u, const f32x4 (&acc)[2][2][4][2], int wr, int wc, int fr, int fq, __attribute__((address_space(3))) unsigned char* xb) const {
        const int lane_ = fq * 16 + fr; (void)lane_;
        f32x4 bg[2], bu[2]; const int j = u.col0 + EPI_COLP(0);
        float ka = -SW_ALPHA * LOG2E, k1 = 1.0f; asm volatile("" : "+v"(ka), "+v"(k1));
        const f32x2 KA = {ka, ka}, K1 = {k1, k1};
#pragma unroll
        for (int n = 0; n < 2; ++n) { bg[n] = *(const f32x4*)(bgu + (size_t)u.e * 2048 + j + 4 * n); bu[n] = *(const f32x4*)(bgu + (size_t)u.e * 2048 + 1024 + j + 4 * n); }
#pragma unroll
        for (int ai = 0; ai < 2; ++ai)
#pragma unroll
            for (int m = 0; m < 4; ++m) { const int row = u.row0 + EPI_ROW(ai, m); f32x4 o[2];
#pragma unroll
                for (int n = 0; n < 2; ++n) { const f32x4 g = acc[ai][0][m][n], up = acc[ai][1][m][n];
#pragma unroll
                    for (int i = 0; i < 4; i += 2) {
                        f32x2 G = (f32x2){g[i], g[i + 1]} + (f32x2){bg[n][i], bg[n][i + 1]}, Uv = (f32x2){up[i], up[i + 1]} + (f32x2){bu[n][i], bu[n][i + 1]};
                        G.x = fminf(G.x, SW_LIMIT); G.y = fminf(G.y, SW_LIMIT);
                        Uv.x = __builtin_amdgcn_fmed3f(Uv.x, -SW_LIMIT, SW_LIMIT); Uv.y = __builtin_amdgcn_fmed3f(Uv.y, -SW_LIMIT, SW_LIMIT);
                        const f32x2 T = G * KA;
                        const f32x2 D = (f32x2){__builtin_amdgcn_exp2f(T.x), __builtin_amdgcn_exp2f(T.y)} + K1;
                        const f32x2 R = {__builtin_amdgcn_rcpf(D.x), __builtin_amdgcn_rcpf(D.y)};
                        const f32x2 O = __builtin_elementwise_fma(Uv, G, G) * R;
                        o[n][i] = O.x; o[n][i + 1] = O.y; } }
                *(u32x4*)(act + (size_t)(row - fr + EPI_XROW) * DFF + u.col0 + wc * 32 + EPI_XCOL) = epi_xpose(xb, pk8(o[0], o[1]), fr, fq, lane_); }
    } };
struct EpiDN { bf16_t* y; const float* bdn; const float* rowgate;
    static constexpr bool PERM = true;
    template <class U> __device__ __forceinline__ void tile(const U& u, const f32x4 (&acc)[2][2][4][2], int wr, int wc, int fr, int fq, __attribute__((address_space(3))) unsigned char* xb) const {
        const int lane_ = fq * 16 + fr;
        f32x4 b[2][2]; float g[2][4];
#pragma unroll
        for (int bj = 0; bj < 2; ++bj)
#pragma unroll
            for (int n = 0; n < 2; ++n) b[bj][n] = *(const f32x4*)(bdn + (size_t)u.e * DM + u.col0 + EPI_COLP(bj) + 4 * n);
#pragma unroll
        for (int ai = 0; ai < 2; ++ai)
#pragma unroll
            for (int m = 0; m < 4; ++m) g[ai][m] = rowgate[(size_t)u.e * ECAP + u.idx0 + EPI_ROW(ai, m)];
#pragma unroll
        for (int ai = 0; ai < 2; ++ai)
#pragma unroll
            for (int m = 0; m < 4; ++m) { const int row = u.row0 + ai * 128 + wr * 64 + m * 16 + EPI_XROW;
#pragma unroll
                for (int bj = 0; bj < 2; ++bj) *(u32x4*)(y + (size_t)row * DM + u.col0 + bj * 128 + wc * 32 + EPI_XCOL) = epi_xpose(xb, pk8((acc[ai][bj][m][0] + b[bj][0]) * g[ai][m], (acc[ai][bj][m][1] + b[bj][1]) * g[ai][m]), fr, fq, lane_); }
    } };

namespace fg {
#define FG_LAS __attribute__((address_space(3)))
typedef short bf16x8 __attribute__((ext_vector_type(8)));
constexpr int BM = 256, BK = 64, HALF = 128, HTB = HALF * BK * 2, STAGE_BYTES = 8 * HTB, NXCD = 8, WGM = 8;
constexpr int GIDX_OFF = 131072 + 10240;
__host__ __device__ __forceinline__ int lds_byte(int r, int c) { const int st = (r >> 4) * 2 + (c >> 5), rr = r & 15, cc = c & 31, ob = rr * 64 + cc * 2; return st * 1024 + (ob ^ (((ob >> 9) & 1) << 5)); }
__host__ __device__ __forceinline__ void stage_rc(int b, int& R, int& C) { const int st = b / 1024, sb = b % 1024, swz = sb ^ (((sb >> 9) & 1) << 5); R = (st >> 1) * 16 + swz / 64; C = (st & 1) * 32 + (swz % 64) / 2; }

struct FUnit { const bf16_t* B;
               const int* gather; int gcount;
               int arow0;
               int row0, col0, e, idx0; };

struct DenseSched {
    const bf16_t* Bt; int K, nM, nN, nwg, G, c;
    __device__ void init(const bf16_t* Bt_, int M, int N, int K_, int G_, int c_) { Bt = Bt_; K = K_; nM = M / BM; nN = N / BM; nwg = nM * nN; G = G_; c = c_; }
    __device__ __forceinline__ bool next(int i, FUnit& u, int) const {
        const long L = (long)i * G + c; if (L >= nwg) return false;
        int wgid = (int)L; { const int q = nwg / NXCD, r = nwg % NXCD, xcd = wgid % NXCD, off = wgid / NXCD; wgid = (xcd < r ? xcd * (q + 1) : r * (q + 1) + (xcd - r) * q) + off; }
        const int nig = WGM * nN, gid = wgid / nig, fm = gid * WGM, gsz = (nM - fm) < WGM ? (nM - fm) : WGM;
        const int pm = fm + ((wgid % nig) % gsz), pn = (wgid % nig) / gsz;
        u.B = Bt + (size_t)pn * BM * K; u.gather = nullptr; u.gcount = 0; u.arow0 = pm * BM; u.row0 = pm * BM; u.col0 = pn * BM; u.e = 0; u.idx0 = 0; return true;
    }
};
template <int DUAL> struct MoeSched {
    const bf16_t* Wt; const unsigned* cnt; const int* rowtok; const FG_LAS int* pre;
    int G, vcu;
    static constexpr int TN = DUAL ? 8 : 4;
    __device__ __forceinline__ bool next(int i, FUnit& u, int lane) const {
        const int L = i * G + vcu; if (L >= pre[NEXP]) return false;
        const int pv = pre[lane < NEXP ? lane : NEXP];
        const int e = __builtin_popcountll(__ballot(lane < NEXP && L >= pv)) - 1;
        const int loc = L - pre[e], J = (pre[e + 1] - pre[e]) / TN;
        int j, nt; if (DUAL) { const int g = loc / (4 * J), r = loc % (4 * J); j = r >> 2; nt = g * 4 + (r & 3); } else { j = loc >> 2; nt = loc & 3; }
        const int mt = pre[e] / TN + j, c = (int)cnt[e];
        if (DUAL) { u.B = Wt + ((size_t)e * 2048 + nt * 256) * DM; u.gather = rowtok + (size_t)e * ECAP + j * BM; u.gcount = c - j * BM; u.arow0 = 0; u.col0 = nt * 128; }
        else { u.B = Wt + ((size_t)e * 1024 + nt * 256) * DFF; u.gather = nullptr; u.gcount = 0; u.arow0 = mt * BM; u.col0 = nt * 256; }
        u.row0 = mt * BM; u.e = e; u.idx0 = j * BM; return true;
    }
};
__device__ __forceinline__ void moe_prefix(const unsigned* cnt, FG_LAS int* pre, int TN, int tid) {
    if (tid == 0) { int acc = 0; for (int e = 0; e < NEXP; ++e) { pre[e] = acc; acc += (((int)cnt[e] + BM - 1) / BM) * TN; } pre[NEXP] = acc; }
    __syncthreads();
}

template <int DUAL, class Epi, class Sched>
__device__ __forceinline__ void gemm_phase(FG_LAS unsigned char* lds, const bf16_t* A, int K, const Sched& S, const Epi& E, const int tid) {
    const int wid = __builtin_amdgcn_readfirstlane(tid >> 6), lane = tid & 63, wr = wid >> 2, wc = wid & 3, fr = lane & 15, fq = lane >> 4;
    const int nt = K / BK;
    int Rr[2], Cc[2]; unsigned voffB[2];
#pragma unroll
    for (int i = 0; i < 2; ++i) { stage_rc(tid * 16 + i * 8192, Rr[i], Cc[i]);
        const int rho = Rr[i] & 31, Rb = Epi::PERM ? ((Rr[i] & ~31) + 8 * ((rho & 15) >> 2) + 4 * (rho >> 4) + (rho & 3)) : Rr[i];
        voffB[i] = (unsigned)(Rb * K + Cc[i]) * 2u; }
    const size_t kstep = (size_t)(BK * 2);
    const size_t hstep = (size_t)HALF * K * 2;
    const unsigned ldsw = (unsigned)wid * 1024u;
    const int aoff = lds_byte(wr * 64 + fr, fq * 8), boff = lds_byte(wc * 32 + fr, fq * 8);
#define FG_SA(b, h) (((b) * 2 + (h)) * HTB)
#define FG_SB(b, h) ((4 + (b) * 2 + (h)) * HTB)
#define FG_STAGEB(bufoff, gbase) do { _Pragma("unroll") for (int _i = 0; _i < 2; ++_i) \
        __builtin_amdgcn_global_load_lds((const unsigned*)((const char*)(gbase) + voffB[_i]), (FG_LAS unsigned*)(lds + (bufoff) + ldsw + _i * 8192), 16, 0, 0); } while (0)
#define FG_STAGEA(bufoff, o0, o1, kb) do { \
        __builtin_amdgcn_global_load_lds((const unsigned*)((const char*)A + (size_t)(o0) + (kb)), (FG_LAS unsigned*)(lds + (bufoff) + ldsw), 16, 0, 0); \
        __builtin_amdgcn_global_load_lds((const unsigned*)((const char*)A + (size_t)(o1) + (kb)), (FG_LAS unsigned*)(lds + (bufoff) + ldsw + 8192), 16, 0, 0); } while (0)
#define FG_LDA(dst, b, h) do { _Pragma("unroll") for (int m = 0; m < 4; ++m) _Pragma("unroll") for (int k = 0; k < 2; ++k) dst[m][k] = *(const FG_LAS bf16x8*)(lds + FG_SA(b, h) + aoff + m * 2048 + k * 1024); } while (0)
#define FG_LDB(dst, b, h) do { _Pragma("unroll") for (int n = 0; n < 2; ++n) _Pragma("unroll") for (int k = 0; k < 2; ++k) dst[n][k] = *(const FG_LAS bf16x8*)(lds + FG_SB(b, h) + boff + n * 2048 + k * 1024); } while (0)
#define FG_MMA(ai, bj, At, Bt) do { __builtin_amdgcn_s_setprio(1); _Pragma("unroll") for (int m = 0; m < 4; ++m) _Pragma("unroll") for (int n = 0; n < 2; ++n) _Pragma("unroll") for (int k = 0; k < 2; ++k) \
        acc[ai][bj][m][n] = __builtin_amdgcn_mfma_f32_16x16x32_bf16(Bt[n][k], At[m][k], acc[ai][bj][m][n], 0, 0, 0); __builtin_amdgcn_s_setprio(0); } while (0)
#define FG_WAIT_V(n) asm volatile("s_waitcnt vmcnt(" #n ")" ::: "memory")
#define FG_WAIT_L(n) asm volatile("s_waitcnt lgkmcnt(" #n ")" ::: "memory")
#define FG_BAR __builtin_amdgcn_s_barrier()
#define FG_SCHED __builtin_amdgcn_sched_barrier(0)
#define FG_AOFFS(u, dst) do { _Pragma("unroll") for (int h = 0; h < 2; ++h) _Pragma("unroll") for (int i = 0; i < 2; ++i) { const int r_ = h * HALF + Rr[i]; int row_; \
        if ((u).gather) row_ = (r_ < (u).gcount) ? (u).gather[r_] : 0; else row_ = (u).arow0 + r_; dst[h][i] = (unsigned)(row_ * K + Cc[i]) * 2u; } } while (0)
    FUnit cur, nxt; int ui = 0;
    if (!S.next(0, cur, lane)) return;
#ifndef FG_KREP
#define FG_KREP 1
#endif
    f32x4 acc[2][2][4][2];
#pragma unroll
    for (int a = 0; a < 2; ++a)
#pragma unroll
        for (int b = 0; b < 2; ++b)
#pragma unroll
            for (int m = 0; m < 4; ++m)
#pragma unroll
                for (int n = 0; n < 2; ++n) acc[a][b][m][n] = (f32x4){0.f, 0.f, 0.f, 0.f};
    bf16x8 At[4][2], B0[2][2], B1[2][2];
    unsigned ao[2][2], an[2][2];
    FG_AOFFS(cur, ao);
    const char* cB = (const char*)cur.B;
    FG_STAGEB(FG_SB(0, 0), cB); FG_STAGEB(FG_SB(0, 1), cB + hstep); FG_STAGEA(FG_SA(0, 0), ao[0][0], ao[0][1], 0); FG_STAGEA(FG_SA(0, 1), ao[1][0], ao[1][1], 0);
    if (wr == 1) FG_BAR;
    FG_WAIT_V(2); FG_BAR;
    FG_STAGEB(FG_SB(1, 0), cB + kstep); FG_STAGEA(FG_SA(1, 0), ao[0][0], ao[0][1], kstep); FG_STAGEB(FG_SB(1, 1), cB + hstep + kstep);
    FG_WAIT_V(6); FG_BAR;
    for (;;) {
        const bool has_next = S.next((ui + 1) / FG_KREP, nxt, lane);
        const bool nx_gather = has_next && nxt.gather != nullptr;
        if (nx_gather) { if (wid == 0) { int lg_ = lane; asm volatile("" : "+v"(lg_)); __builtin_amdgcn_global_load_lds((const unsigned*)(nxt.gather + lg_ * 4), (FG_LAS unsigned*)(lds + GIDX_OFF), 16, 0, 0); } }
        else if (has_next) { FG_AOFFS(nxt, an); } else {
#pragma unroll
            for (int h = 0; h < 2; ++h)
#pragma unroll
                for (int i = 0; i < 2; ++i) an[h][i] = ao[h][i]; }
        const char* nB = has_next ? (const char*)nxt.B : cB;
        for (int t = 0; t < nt; t += 2) {
            const bool last = (t == nt - 2);
            const size_t k1 = (size_t)(t + 1) * kstep, k2 = last ? 0 : (size_t)(t + 2) * kstep, k3 = k2 + kstep;
            const char* b2 = (last ? nB : cB) + k2; const char* b3 = b2 + kstep;
            if (last && nx_gather) {
#pragma unroll
                for (int h = 0; h < 2; ++h)
#pragma unroll
                    for (int i = 0; i < 2; ++i) { const int r_ = h * HALF + Rr[i]; const int row_ = (r_ < nxt.gcount) ? *(const FG_LAS int*)(lds + GIDX_OFF + r_ * 4) : 0; an[h][i] = (unsigned)(row_ * K + Cc[i]) * 2u; } }
            const unsigned s00 = last ? an[0][0] : ao[0][0], s01 = last ? an[0][1] : ao[0][1], s10 = last ? an[1][0] : ao[1][0], s11 = last ? an[1][1] : ao[1][1];
            FG_LDB(B0, 0, 0); FG_LDB(B1, 0, 1); FG_SCHED; FG_LDA(At, 0, 0); FG_STAGEA(FG_SA(1, 1), ao[1][0], ao[1][1], k1);
            FG_WAIT_V(8); FG_WAIT_L(0); FG_BAR; FG_MMA(0, 0, At, B0); FG_MMA(0, 1, At, B1); FG_BAR; FG_SCHED;
            FG_LDA(At, 0, 1); FG_STAGEB(FG_SB(0, 0), b2); FG_STAGEB(FG_SB(0, 1), b2 + hstep); FG_STAGEA(FG_SA(0, 0), s00, s01, k2);
            FG_WAIT_V(8); FG_WAIT_L(0); FG_BAR; FG_MMA(1, 0, At, B0); FG_MMA(1, 1, At, B1); FG_BAR; FG_SCHED;
            FG_LDB(B0, 1, 0); FG_LDB(B1, 1, 1); FG_SCHED; FG_LDA(At, 1, 0); FG_STAGEA(FG_SA(0, 1), s10, s11, k2);
            FG_WAIT_V(8); FG_WAIT_L(0); FG_BAR; FG_MMA(0, 0, At, B0); FG_MMA(0, 1, At, B1); FG_BAR; FG_SCHED;
            FG_LDA(At, 1, 1); FG_STAGEB(FG_SB(1, 0), b3); FG_STAGEB(FG_SB(1, 1), b3 + hstep); FG_STAGEA(FG_SA(1, 0), s00, s01, k3);
            FG_WAIT_V(8); FG_WAIT_L(0); FG_BAR; FG_MMA(1, 0, At, B0); FG_MMA(1, 1, At, B1); FG_BAR; FG_SCHED;
        }
        if (wr == 0) FG_BAR;
        if (ui % FG_KREP == FG_KREP - 1) { int le_ = lane; asm volatile("" : "+v"(le_));
            E.tile(cur, acc, wr, wc, le_ & 15, le_ >> 4, lds + 131072 + (wid < 4 ? 512 + wid * 1280 : 11264 + (wid - 4) * 1280)); }
        if (!has_next) break;
#pragma unroll
        for (int a = 0; a < 2; ++a)
#pragma unroll
            for (int b = 0; b < 2; ++b)
#pragma unroll
                for (int m = 0; m < 4; ++m)
#pragma unroll
                    for (int n = 0; n < 2; ++n) acc[a][b][m][n] = (f32x4){0.f, 0.f, 0.f, 0.f};
        cur = nxt; cB = nB; ++ui;
#pragma unroll
        for (int h = 0; h < 2; ++h)
#pragma unroll
            for (int i = 0; i < 2; ++i) ao[h][i] = an[h][i];
        if (wr == 1) FG_BAR;
    }
    FG_WAIT_V(0);
    FG_BAR;
#undef FG_SA
#undef FG_SB
#undef FG_STAGEA
#undef FG_STAGEB
#undef FG_LDA
#undef FG_LDB
#undef FG_MMA
#undef FG_WAIT_V
#undef FG_WAIT_L
#undef FG_BAR
#undef FG_SCHED
#undef FG_AOFFS
}
}
constexpr int FAST_LDS = 147456;
constexpr int MISC_OFF = 131072;
__device__ __forceinline__ int vcu_of(int bx, int G) { return (G % 8 == 0) ? (bx % 8) * (G / 8) + bx / 8 : bx; }

namespace at {
#define AT_LAS __attribute__((address_space(3)))
typedef short bf16x8 __attribute__((ext_vector_type(8)));
typedef short s16x4 __attribute__((ext_vector_type(4)));
typedef short v4i16_t __attribute__((ext_vector_type(4)));
typedef float f32x16 __attribute__((ext_vector_type(16)));
typedef __bf16 bf16x2_t __attribute__((ext_vector_type(2)));
__device__ __forceinline__ unsigned cvtpk(float lo, float hi) { f32x2 v = {lo, hi}; bf16x2_t b = __builtin_convertvector(v, bf16x2_t); return __builtin_bit_cast(unsigned, b); }
__device__ __forceinline__ s16x4 vtr(const AT_LAS char* p) { return __builtin_bit_cast(s16x4, __builtin_amdgcn_ds_read_tr16_b64_v4i16((AT_LAS v4i16_t*)p)); }
__device__ __forceinline__ void glds16(const void* g, AT_LAS char* l) { unsigned keep; const unsigned dst = (unsigned)__builtin_amdgcn_readfirstlane((int)(unsigned)(uintptr_t)l);
    asm volatile("s_mov_b32 %0, m0\n\ts_mov_b32 m0, %2\n\ts_nop 0\n\tglobal_load_lds_dwordx4 %1, off\n\ts_mov_b32 m0, %0" : "=&s"(keep) : "v"(g), "s"(dst) : "memory"); }
__device__ __forceinline__ void glds16x4(unsigned voff, const void* sbase, AT_LAS char* l) { unsigned keep; const unsigned dst = (unsigned)__builtin_amdgcn_readfirstlane((int)(unsigned)(uintptr_t)l);
    asm volatile("s_mov_b32 %0, m0\n\ts_mov_b32 m0, %3\n\ts_nop 0\n\tglobal_load_lds_dwordx4 %1, %2\n\tglobal_load_lds_dwordx4 %1, %2 offset:1024\n\tglobal_load_lds_dwordx4 %1, %2 offset:2048\n\tglobal_load_lds_dwordx4 %1, %2 offset:3072\n\ts_mov_b32 m0, %0"
                 : "=&s"(keep) : "v"(voff), "s"(sbase), "s"(dst) : "memory"); }
__device__ __forceinline__ void glds16x2(unsigned voff, const void* sbase, AT_LAS char* l) { unsigned keep; const unsigned dst = (unsigned)__builtin_amdgcn_readfirstlane((int)(unsigned)(uintptr_t)l);
    asm volatile("s_mov_b32 %0, m0\n\ts_mov_b32 m0, %3\n\ts_nop 0\n\tglobal_load_lds_dwordx4 %1, %2\n\tglobal_load_lds_dwordx4 %1, %2 offset:2048\n\ts_mov_b32 m0, %0"
                 : "=&s"(keep) : "v"(voff), "s"(sbase), "s"(dst) : "memory"); }
__device__ __forceinline__ float swapmax(float x) { auto rr = __builtin_amdgcn_permlane32_swap(__float_as_uint(x), __float_as_uint(x), false, false); return fmaxf(__uint_as_float(rr[0]), __uint_as_float(rr[1])); }
__device__ __forceinline__ float swapsum(float x) { auto rr = __builtin_amdgcn_permlane32_swap(__float_as_uint(x), __float_as_uint(x), false, false); return __uint_as_float(rr[0]) + __uint_as_float(rr[1]); }
__device__ __forceinline__ f32x16 qk32(const AT_LAS char* kblk, const bf16x8 (&qr)[4], int r32, int hi) {
    bf16x8 a[4]; const AT_LAS char* rp = kblk + r32 * 128; const int x = r32 & 7;
#pragma unroll
    for (int d0 = 0; d0 < 4; ++d0) a[d0] = *(const AT_LAS bf16x8*)(rp + (((2 * d0 + hi) ^ x) << 4));
    f32x16 p = {};
#pragma unroll
    for (int d0 = 0; d0 < 4; ++d0) p = __builtin_amdgcn_mfma_f32_32x32x16_bf16(a[d0], qr[d0], p, 0, 0, 0);
    return p;
}
__device__ __forceinline__ void qk64(f32x16& p0, f32x16& p1, const AT_LAS char* kt, const bf16x8 (&qr)[4], int r32, int hi) {
    bf16x8 a[4], b[4]; const AT_LAS char* rp = kt + r32 * 128; const int x = r32 & 7;
#pragma unroll
    for (int d0 = 0; d0 < 4; ++d0) { const int so = ((2 * d0 + hi) ^ x) << 4; a[d0] = *(const AT_LAS bf16x8*)(rp + so); b[d0] = *(const AT_LAS bf16x8*)(rp + 4096 + so); }
    p0 = f32x16{}; p1 = f32x16{};
#pragma unroll
    for (int d0 = 0; d0 < 4; ++d0) { p0 = __builtin_amdgcn_mfma_f32_32x32x16_bf16(a[d0], qr[d0], p0, 0, 0, 0); p1 = __builtin_amdgcn_mfma_f32_32x32x16_bf16(b[d0], qr[d0], p1, 0, 0, 0); }
}
__device__ __forceinline__ void pack_p(const f32x16& p, bf16x8& pa0, bf16x8& pa1) {
    u32x4 w0, w1;
    w0.x = cvtpk(p[0], p[1]); w0.y = cvtpk(p[2], p[3]); w0.z = cvtpk(p[4], p[5]); w0.w = cvtpk(p[6], p[7]);
    w1.x = cvtpk(p[8], p[9]); w1.y = cvtpk(p[10], p[11]); w1.z = cvtpk(p[12], p[13]); w1.w = cvtpk(p[14], p[15]);
    pa0 = __builtin_bit_cast(bf16x8, w0); pa1 = __builtin_bit_cast(bf16x8, w1);
}
__device__ __forceinline__ void v_lane_offs(int lane, int hi, int (&a)[2]) {
    const int q = (lane & 15) >> 2, cl = 2 * ((lane >> 4) & 1) + ((lane & 3) >> 1), sub = (lane & 1) * 8;
#pragma unroll
    for (int sec = 0; sec < 2; ++sec) { const int kl = 4 * hi + q + 8 * sec; a[sec] = kl * 128 + ((cl ^ ((kl >> 1) & 7)) << 4) + sub; }
}
template <int NKS> __device__ __forceinline__ void pv_tile(f32x16 (&o)[2], const bf16x8 (&pa)[NKS], const AT_LAS char* vt, int lane, int hi) {
    int a[2]; v_lane_offs(lane, hi, a);
    s16x4 lo[2][NKS], hh[2][NKS];
#pragma unroll
    for (int d0 = 0; d0 < 2; ++d0)
#pragma unroll
        for (int ks = 0; ks < NKS; ++ks) { lo[d0][ks] = vtr(vt + ks * 2048 + (a[0] ^ (d0 * 64))); hh[d0][ks] = vtr(vt + ks * 2048 + (a[1] ^ (d0 * 64))); }
#pragma unroll
    for (int ks = 0; ks < NKS; ++ks)
#pragma unroll
        for (int d0 = 0; d0 < 2; ++d0) { const bf16x8 b = (bf16x8){lo[d0][ks][0], lo[d0][ks][1], lo[d0][ks][2], lo[d0][ks][3], hh[d0][ks][0], hh[d0][ks][1], hh[d0][ks][2], hh[d0][ks][3]};
            o[d0] = __builtin_amdgcn_mfma_f32_32x32x16_bf16(pa[ks], b, o[d0], 0, 0, 0); }
}
__device__ __forceinline__ void pv32(f32x16 (&o)[2], const f32x16& p, const AT_LAS char* vt, int lane, int hi) { bf16x8 pa[2]; pack_p(p, pa[0], pa[1]); pv_tile<2>(o, pa, vt, lane, hi); }
__device__ __forceinline__ void pv64(f32x16 (&o)[2], const f32x16& p0, const f32x16& p1, const AT_LAS char* vt, int lane, int hi) { bf16x8 pa[4]; pack_p(p0, pa[0], pa[1]); pack_p(p1, pa[2], pa[3]); pv_tile<4>(o, pa, vt, lane, hi); }
template <int NBK> __device__ __forceinline__ void softmax_step(f32x16 (&p)[NBK], float& m, float& l, f32x16 (&o)[2], AT_LAS float* wsf, int r32, int hi) {
    float mt = p[0][0];
#pragma unroll
    for (int b = 0; b < NBK; ++b)
#pragma unroll
        for (int r = 0; r < 16; ++r) mt = fmaxf(mt, p[b][r]);
    mt = swapmax(mt);
    const float mn = fmaxf(m, mt);
    if (__any(mt > m + 4.0f)) {
        const float alpha = __builtin_amdgcn_exp2f(m - mn);
        l *= alpha;
        if (hi == 0) wsf[r32] = alpha;
#pragma unroll
        for (int g = 0; g < 4; ++g) { const f32x4 a = *(const AT_LAS f32x4*)(wsf + 8 * g + 4 * hi);
#pragma unroll
            for (int i = 0; i < 4; ++i) { o[0][4 * g + i] *= a[i]; o[1][4 * g + i] *= a[i]; } }
        m = mn;
    }
    float s = 0.f;
#pragma unroll
    for (int b = 0; b < NBK; ++b)
#pragma unroll
        for (int r = 0; r < 16; ++r) { p[b][r] = __builtin_amdgcn_exp2f(p[b][r] - m); s += p[b][r]; }
    l += s;
}
__device__ __forceinline__ void attn_store(const f32x16 (&o)[2], float l, AT_LAS float* wsf, AT_LAS bf16_t* stg, bf16_t* Og, size_t rs, int lane, int r32, int hi) {
    const float lt = swapsum(l);
    if (hi == 0) wsf[32 + r32] = 1.0f / lt;
#pragma unroll
    for (int g = 0; g < 4; ++g) { const f32x4 rl = *(const AT_LAS f32x4*)(wsf + 32 + 8 * g + 4 * hi);
#pragma unroll
        for (int i = 0; i < 4; ++i) { const int orow = 8 * g + 4 * hi + i;
            stg[orow * 64 + r32] = (bf16_t)f2bf(o[0][4 * g + i] * rl[i]); stg[orow * 64 + 32 + r32] = (bf16_t)f2bf(o[1][4 * g + i] * rl[i]); } }
#pragma unroll
    for (int i = 0; i < 4; ++i) { const int row = i * 8 + (lane >> 3), ch = lane & 7; const u32x4 v = *(const AT_LAS u32x4*)(stg + row * 64 + ch * 8); *(u32x4*)(Og + (size_t)row * rs + ch * 8) = v; }
}

constexpr int NRING = 4, LK = 0, LV = NRING * 8192, LW = 2 * NRING * 8192, LO = LW + 2048, LC = LO + 8 * 4096, ATT_LDS = LC + NRING * 1024;
__device__ __forceinline__ void qk64x(f32x16& p0, f32x16& p1, const AT_LAS char* kt, const bf16x8 (&qr)[4], const bf16x8 ax0, const bf16x8 ax1, const bf16x8 qx, int r32, int hi) {
    bf16x8 a[4], b[4]; const AT_LAS char* rp = kt + r32 * 128; const int x = r32 & 7;
#pragma unroll
    for (int d0 = 0; d0 < 4; ++d0) { const int so = ((2 * d0 + hi) ^ x) << 4; a[d0] = *(const AT_LAS bf16x8*)(rp + so); b[d0] = *(const AT_LAS bf16x8*)(rp + 4096 + so); }
    p0 = __builtin_amdgcn_mfma_f32_32x32x16_bf16(ax0, qx, (f32x16){}, 0, 0, 0); p1 = __builtin_amdgcn_mfma_f32_32x32x16_bf16(ax1, qx, (f32x16){}, 0, 0, 0);
#pragma unroll
    for (int d0 = 0; d0 < 4; ++d0) { p0 = __builtin_amdgcn_mfma_f32_32x32x16_bf16(a[d0], qr[d0], p0, 0, 0, 0); p1 = __builtin_amdgcn_mfma_f32_32x32x16_bf16(b[d0], qr[d0], p1, 0, 0, 0); }
}
__device__ __forceinline__ bf16x8 make_qx(float cm, int hi) {
    const unsigned hb = cvtpk(cm, 0.f) & 0xffffu; const float hf = __uint_as_float(hb << 16); const unsigned lb = cvtpk(cm - hf, 0.f) & 0xffffu;
    u32x4 w = (u32x4){hb | (lb << 16), 0x3F803F80u, 0u, 0u}; if (hi) w = (u32x4){0u, 0u, 0u, 0u};
    return __builtin_bit_cast(bf16x8, w);
}
constexpr float AT_THR = 4.0f;
template <int MODE> __device__ __forceinline__ void attn_block_unit(AT_LAS char* lds, const bf16_t* Qp, int ldq, const bf16_t* Kp, const bf16_t* Vp, int ldkv, int NT, int q0, const float* cl, const bf16_t* ckb, bf16_t* Op, int ldo, const int tid) {
    const int lane = tid & 63, r32 = lane & 31, hi = lane >> 5; const int wid = __builtin_amdgcn_readfirstlane(tid >> 6);
    AT_LAS float* wsf = (AT_LAS float*)(lds + LW) + wid * 64; AT_LAS bf16_t* stg = (AT_LAS bf16_t*)(lds + LO) + wid * 2048;
    const int qpos = q0 + wid * 32 + r32;
    const int lrow = wid * 8 + (lane >> 3), lslot = lane & 7;
    const bf16_t* ksrc = Kp + (size_t)lrow * ldkv + ((lslot ^ (lrow & 7)) << 3);
    const bf16_t* vsrc = Vp + (size_t)lrow * ldkv + ((lslot ^ ((lrow >> 1) & 7)) << 3);
    const bool xw = (MODE == 0) && (wid == 0);
#define AT_LOAD(t, bs) do { const int tt_ = NT - 1 - (t); const size_t to_ = (size_t)tt_ * 64 * ldkv; glds16(ksrc + to_, lds + LK + (bs) * 8192 + wid * 1024); glds16(vsrc + to_, lds + LV + (bs) * 8192 + wid * 1024); \
        if (xw) glds16(ckb + ((size_t)(tt_ * 64 + lane) << 3), lds + LC + (bs) * 1024); } while (0)
#define AT_WAITN(n) do { if (xw) { if ((n) >= 2) asm volatile("s_waitcnt vmcnt(6) lgkmcnt(0)" ::: "memory"); else if ((n) == 1) asm volatile("s_waitcnt vmcnt(3) lgkmcnt(0)" ::: "memory"); else asm volatile("s_waitcnt vmcnt(0) lgkmcnt(0)" ::: "memory"); } \
        else { if ((n) >= 2) asm volatile("s_waitcnt vmcnt(4) lgkmcnt(0)" ::: "memory"); else if ((n) == 1) asm volatile("s_waitcnt vmcnt(2) lgkmcnt(0)" ::: "memory"); else asm volatile("s_waitcnt vmcnt(0) lgkmcnt(0)" ::: "memory"); } } while (0)
    AT_LOAD(0, 0); if (NT > 1) AT_LOAD(1, 1); if (NT > 2) AT_LOAD(2, 2);
    bf16x8 qr[4];
#pragma unroll
    for (int d0 = 0; d0 < 4; ++d0) qr[d0] = *(const bf16x8*)(Qp + (size_t)qpos * ldq + d0 * 16 + hi * 8);
    float l = 0.f, cq = 0.f; if (MODE == 0) cq = cl[qpos];
    f32x16 o[2]; o[0] = f32x16{}; o[1] = f32x16{};
#pragma unroll
    for (int d0 = 0; d0 < 4; ++d0) asm volatile("" : "+v"(qr[d0]));
    asm volatile("" : "+v"(cq));
    float cm = cq;
    bf16x8 qx = make_qx(cm, hi);
    unsigned one2 = 0x3F803F80u, zz = 0u; asm volatile("" : "+v"(one2), "+v"(zz));
    const bf16x8 ax_const = __builtin_bit_cast(bf16x8, (u32x4){one2, zz, zz, zz});
    bool first = true;
#define AT_WAIT1(more) do { if (more) { if (xw) asm volatile("s_waitcnt vmcnt(3) lgkmcnt(0)" ::: "memory"); else asm volatile("s_waitcnt vmcnt(2) lgkmcnt(0)" ::: "memory"); } else asm volatile("s_waitcnt vmcnt(0) lgkmcnt(0)" ::: "memory"); } while (0)
#define AT_LIVE(t_) ((MODE == 1) || ((NT - 1 - (t_)) * 64 <= q0 + wid * 32 + 31))
#define AT_QK(t_, P) do { const int bq_ = (t_) & (NRING - 1), kq_ = (NT - 1 - (t_)) * 64; bf16x8 ax0_ = ax_const, ax1_ = ax_const; \
        if (MODE == 0) { ax0_ = *(const AT_LAS bf16x8*)(lds + LC + bq_ * 1024 + r32 * 16); ax1_ = *(const AT_LAS bf16x8*)(lds + LC + bq_ * 1024 + 512 + r32 * 16); } \
        qk64x(P[0], P[1], lds + LK + bq_ * 8192, qr, ax0_, ax1_, qx, r32, hi); \
        if (MODE == 0 && kq_ + 63 > q0 + wid * 32) {                                      \
            _Pragma("unroll") for (int b = 0; b < 2; ++b) _Pragma("unroll") for (int r = 0; r < 16; ++r) { const int key = kq_ + b * 32 + (r & 3) + 8 * (r >> 2) + 4 * hi; if (key > qpos) P[b][r] = -INFINITY; } } } while (0)
#define AT_STEP(t_, PC, PN) do { const int bs = (t_) & (NRING - 1); \
        if ((t_) + 3 < NT) AT_LOAD((t_) + 3, ((t_) + 3) & (NRING - 1));                   \
        const bool ln_ = ((t_) + 1 < NT) && AT_LIVE((t_) + 1); \
        if (ln_) AT_QK((t_) + 1, PN); \
        if (AT_LIVE(t_)) { \
            float mt = PC[0][0]; \
            _Pragma("unroll") for (int b = 0; b < 2; ++b) _Pragma("unroll") for (int r = 0; r < 16; ++r) mt = fmaxf(mt, PC[b][r]); \
            mt = swapmax(mt); \
            if (first || __any(mt > AT_THR)) {                                            \
                const float dl = first ? mt : fmaxf(mt, 0.f); \
                cm -= dl; qx = make_qx(cm, hi); \
                _Pragma("unroll") for (int b = 0; b < 2; ++b) _Pragma("unroll") for (int r = 0; r < 16; ++r) PC[b][r] -= dl; \
                if (ln_) { _Pragma("unroll") for (int b = 0; b < 2; ++b) _Pragma("unroll") for (int r = 0; r < 16; ++r) PN[b][r] -= dl; } \
                if (!first) { const float alpha = __builtin_amdgcn_exp2f(-dl); l *= alpha; \
                    if (hi == 0) wsf[r32] = alpha; \
                    _Pragma("unroll") for (int g = 0; g < 4; ++g) { const f32x4 a = *(const AT_LAS f32x4*)(wsf + 8 * g + 4 * hi); \
                        _Pragma("unroll") for (int i = 0; i < 4; ++i) { o[0][4 * g + i] *= a[i]; o[1][4 * g + i] *= a[i]; } } } \
                first = false; \
            } \
            float sm = 0.f; \
            _Pragma("unroll") for (int b = 0; b < 2; ++b) _Pragma("unroll") for (int r = 0; r < 16; ++r) { PC[b][r] = __builtin_amdgcn_exp2f(PC[b][r]); sm += PC[b][r]; } \
            l += sm; \
            pv64(o, PC[0], PC[1], lds + LV + bs * 8192, lane, hi); \
        } \
        AT_WAIT1((t_) + 3 < NT);                                                           \
        __builtin_amdgcn_s_barrier(); } while (0)
    AT_WAIT1(NT > 2);
    __builtin_amdgcn_s_barrier();
    f32x16 pa[2], pb[2];
    if (AT_LIVE(0)) AT_QK(0, pa);
    for (int t = 0; t < NT; t += 2) { AT_STEP(t, pa, pb); AT_STEP(t + 1, pb, pa); }
#undef AT_STEP
#undef AT_QK
#undef AT_LIVE
#undef AT_WAIT1
#undef AT_LOAD
#undef AT_WAITN
    attn_store(o, l, wsf, stg, Op + (size_t)(q0 + wid * 32) * ldo, (size_t)ldo, lane, r32, hi);
}

constexpr int DW_BYTES = 16384;
__device__ __forceinline__ void attn_dil_wave(AT_LAS char* lds0, AT_LAS char* wl, AT_LAS float* wsf, const bf16_t* QKV, bf16_t* MERGED, int b, int hh, int ib, int rho, int lane) {
    const int r32 = lane & 31, hi = lane >> 5, w8 = rho & 7, h8 = rho >> 3;
    float m = -1e30f, l = 0.f; f32x16 o[2]; o[0] = f32x16{}; o[1] = f32x16{};
    const size_t rowb = (size_t)b * SEQ;
    const unsigned vK = (unsigned)((lane >> 3) * 128 + (((lane & 7) ^ ((lane >> 3) & 7)) << 4)), vV0 = (unsigned)((lane >> 3) * 128 + (((lane & 7) ^ (lane >> 4)) << 4)), vV1 = (unsigned)((lane >> 3) * 128 + (((lane & 7) ^ ((lane >> 4) + 4)) << 4));
#define AT_DLOAD(KB, LO, tt, bs) do { AT_LAS char* bb_ = wl + (bs) * 8192; const char* kt_ = (const char*)(KB) + (size_t)((LO) + 32 * (tt)) * 128; \
            at::glds16x4(vK, kt_, bb_); at::glds16x2(vV0, kt_ + LA_K * 2, bb_ + 4096); at::glds16x2(vV1, kt_ + LA_K * 2 + 1024, bb_ + 4096 + 1024); } while (0)
#define AT_DTILES(QR, KB, LO, NTILE, LQ) do { \
        AT_DLOAD(KB, LO, 0, 0); \
        asm volatile("s_waitcnt vmcnt(0)" ::: "memory"); \
        for (int tt = 0; tt < (NTILE); ++tt) { \
            const int bs = tt & 1; \
            if (tt + 1 < (NTILE)) AT_DLOAD(KB, LO, tt + 1, bs ^ 1); \
            f32x16 p[1]; p[0] = qk32(wl + bs * 8192, QR, r32, hi); \
            const unsigned rel = (unsigned)((LO) + 32 * tt + 4 * hi - ((LQ) - 128));        \
            _Pragma("unroll") for (int r = 0; r < 16; ++r) { if (rel + (unsigned)((r & 3) + 8 * (r >> 2)) > 128u) p[0][r] = -INFINITY; } \
            softmax_step<1>(p, m, l, o, wsf, r32, hi); \
            pv32(o, p[0], wl + bs * 8192 + 4096, lane, hi); \
            asm volatile("s_waitcnt vmcnt(0) lgkmcnt(0)" ::: "memory"); \
        } } while (0)
    {
        const int j = r32 >> 3, r = r32 & 7, i0 = 4 * w8 + j, rho0 = 8 * h8 + r;
        const int lq = 16 * (32 * ib + i0) + rho0;
        const int tmin = 16 * (32 * ib + 4 * w8) + 8 * h8, lo = tmin > 128 ? tmin - 128 : 0, hiL = tmin + 55, ntile = ((hiL - lo) >> 5) + 1;
        const int gb = b * 4 + hh;
        const bf16_t* qrow = QKV + ((size_t)((gb * 16 + rho0) * 128 + 32 * ib + i0) << 6);
        const bf16_t* kbase = QKV + LA_K + ((size_t)(gb * SEQ) << 6);
        bf16x8 qr[4];
#pragma unroll
        for (int d0 = 0; d0 < 4; ++d0) qr[d0] = *(const bf16x8*)(qrow + d0 * 16 + hi * 8);
        AT_DTILES(qr, kbase, lo, ntile, lq);
        __syncthreads();
        AT_LAS float* X = (AT_LAS float*)lds0; AT_LAS float* ML = X + 8 * 32 * 64;
#pragma unroll
        for (int jj = 0; jj < 16; ++jj) { const int qh = (jj & 3) + 8 * (jj >> 2) + 4 * hi, dst = ((qh & 7) * 32 + 4 * w8 + (qh >> 3)) * 64 + r32;
            X[dst] = o[0][jj]; X[dst + 32] = o[1][jj]; }
        *(AT_LAS f32x2*)(ML + ((r * 32 + i0) * 2 + hi) * 2) = (f32x2){m, l};
        __syncthreads();
#pragma unroll
        for (int jj = 0; jj < 16; ++jj) { const int row = (jj & 3) + 8 * (jj >> 2) + 4 * hi, src = (w8 * 32 + row) * 64 + r32;
            o[0][jj] = X[src]; o[1][jj] = X[src + 32]; }
        { const f32x2 ml = *(const AT_LAS f32x2*)(ML + ((w8 * 32 + r32) * 2 + hi) * 2); m = ml.x; l = ml.y; }
        __syncthreads();
    }
    for (int g = 1; g < 3; ++g) {
        const int dsh = 2 * g, d = 1 << dsh, sigma = 16 >> dsh, rd = rho & (d - 1), rhod = rho >> dsh;
        const int lq = sigma * (32 * ib + r32) + rhod;
        const int lq0 = sigma * 32 * ib + rhod, lo = lq0 > 128 ? lq0 - 128 : 0, hiL = lq0 + 31 * sigma, ntile = ((hiL - lo) >> 5) + 1;
        const int gb = (g * 8 + b) * 4 + hh;
        const bf16_t* qbase = QKV + ((size_t)((gb * 16 + rho) * 128 + 32 * ib) << 6);
        const bf16_t* kbase = QKV + LA_K + ((size_t)(gb * SEQ + rd * (SEQ >> dsh)) << 6);
        bf16x8 qr[4];
#pragma unroll
        for (int d0 = 0; d0 < 4; ++d0) qr[d0] = *(const bf16x8*)(qbase + r32 * 64 + d0 * 16 + hi * 8);
        AT_DTILES(qr, kbase, lo, ntile, lq);
    }
#undef AT_DTILES
#undef AT_DLOAD
    attn_store(o, l, wsf, (AT_LAS bf16_t*)wl, MERGED + (rowb + 16 * 32 * ib + rho) * A_OUT + hh * 64, (size_t)16 * A_OUT, lane, r32, hi);
}
}

__device__ __forceinline__ void phase_attn_a(AT_LAS char* lds, const bf16_t* QKV, const bf16_t* MKV, bf16_t* MERGED, int G, int vcu, const int tid) {
    const int lane = tid & 63, wid = __builtin_amdgcn_readfirstlane(tid >> 6);
    for (int un = vcu; un < 256; un += G) {
        const int b = un >> 5, hh = (un >> 3) & 3, ib = (un >> 1) & 3, rho = (un & 1) * 8 + wid;
        at::attn_dil_wave(lds, lds + wid * at::DW_BYTES, (AT_LAS float*)(lds + 131072 + 8192 + wid * 256), QKV, MERGED, b, hh, ib, rho, lane);
    }
    __syncthreads();
    for (int un = vcu; un < 256; un += G) {
        const int b = un >> 5, h = (un >> 3) & 3, qb = un & 7;
        at::attn_block_unit<1>(lds, QKV + LA_QM + ((size_t)((b * 4 + h) * SEQ) << 6), 64, MKV + (size_t)b * MEM_LEN * 512 + h * 64, MKV + (size_t)b * MEM_LEN * 512 + 256 + h * 64, 512, 4, qb * 256, nullptr, nullptr,
                                 MERGED + (size_t)b * SEQ * A_OUT + 256 + h * 64, A_OUT, tid);
    }
}
__device__ __forceinline__ void fox_unit(AT_LAS char* lds, const bf16_t* QKV, const float* CUM, const bf16_t* CKB, bf16_t* MERGED, int bh, int qb, const int tid) {
    const int b = bh / NFOX, h = bh % NFOX;
    const size_t ho = (size_t)(bh * SEQ) << 6;
    at::attn_block_unit<0>(lds, QKV + LB_QF + ho, 64, QKV + ho, QKV + LB_V + ho, 64, 4 * (qb + 1), qb * 256,
                             CUM + (size_t)bh * SEQ, CKB + ((size_t)bh * SEQ << 3), MERGED + (size_t)b * SEQ * B_OUT + h * 64, B_OUT, tid);
}
__device__ __forceinline__ void phase_attn_b(AT_LAS char* lds, const bf16_t* QKV, const float* CUM, const bf16_t* CKB, const bf16_t* MKV, bf16_t* MERGED, int G, int vcu, const int tid) {
    if (G == 256) {
        const int grp = vcu >> 3, s = vcu & 7;
        const unsigned tq[8] = {0x704000u, 0x713010u, 0x722011u, 0x605001u, 0x614102u, 0x623121u, 0x514212u, 0x523222u};
        unsigned code = 0;
#pragma unroll
        for (int i = 0; i < 8; ++i) if (s == i) code = tq[i];
#pragma unroll 1
        for (int k = 0; k < 3; ++k) { const int qb = (code >> (20 - 8 * k)) & 15, pr = (code >> (16 - 8 * k)) & 15; fox_unit(lds, QKV, CUM, CKB, MERGED, grp * 3 + pr, qb, tid); }
    } else {
        for (int un = vcu; un < NB * NFOX * 8; un += G) { const int qb = 7 - un / (NB * NFOX), bh = un % (NB * NFOX); fox_unit(lds, QKV, CUM, CKB, MERGED, bh, qb, tid); }
    }
    for (int un = vcu; un < 256; un += G) {
        const int b = un >> 5, h = (un >> 3) & 3, qb = un & 7;
        at::attn_block_unit<1>(lds, QKV + LB_QM + ((size_t)((b * 4 + h) * SEQ) << 6), 64, MKV + (size_t)b * MEM_LEN * 512 + h * 64, MKV + (size_t)b * MEM_LEN * 512 + 256 + h * 64, 512, 4, qb * 256, nullptr, nullptr,
                                 MERGED + (size_t)b * SEQ * B_OUT + 768 + h * 64, B_OUT, tid);
    }
}
__device__ __forceinline__ void load_wT(float* wT, const float* W, int ldw, int coloff, int nw, int tid) {
    const int nch = nw >> 2;
    for (int i = tid; i < DM * nch; i += 512) { const int d = i & (DM - 1), k = i >> 10; const f32x4 w = *(const f32x4*)(W + (size_t)d * ldw + coloff + 4 * k);
        wT[(4 * k + 0) * DM + d] = w.x; wT[(4 * k + 1) * DM + d] = w.y; wT[(4 * k + 2) * DM + d] = w.z; wT[(4 * k + 3) * DM + d] = w.w; }
}
__device__ __forceinline__ void ln_rows(f32x4 (&v)[4], const float* g, const float* b, int lane) {
    float s = 0.f, q = 0.f;
#pragma unroll
    for (int j = 0; j < 4; ++j) { s += (v[j].x + v[j].y) + (v[j].z + v[j].w); q += (v[j].x * v[j].x + v[j].y * v[j].y) + (v[j].z * v[j].z + v[j].w * v[j].w); }
#pragma unroll
    for (int o = 1; o < 64; o <<= 1) { s += shx(s, o, lane); q += shx(q, o, lane); }
    const float mean = s * (1.f / DM), var = fmaxf(q * (1.f / DM) - mean * mean, 0.f);
    const float rstd = 1.0f / sqrtf(var + LN_EPS);
#pragma unroll
    for (int j = 0; j < 4; ++j) { const f32x4 gg = ((const f32x4*)g)[64 * j + lane], bb = ((const f32x4*)b)[64 * j + lane]; v[j] = (v[j] - mean) * rstd * gg + bb; }
}
__device__ __forceinline__ void ln_rows2(f32x4 (&v0)[4], f32x4 (&v1)[4], const float* g, const float* b, int lane) {
    float s0 = 0.f, q0 = 0.f, s1 = 0.f, q1 = 0.f;
#pragma unroll
    for (int j = 0; j < 4; ++j) { s0 += (v0[j].x + v0[j].y) + (v0[j].z + v0[j].w); q0 += (v0[j].x * v0[j].x + v0[j].y * v0[j].y) + (v0[j].z * v0[j].z + v0[j].w * v0[j].w);
                                  s1 += (v1[j].x + v1[j].y) + (v1[j].z + v1[j].w); q1 += (v1[j].x * v1[j].x + v1[j].y * v1[j].y) + (v1[j].z * v1[j].z + v1[j].w * v1[j].w); }
#pragma unroll
    for (int o = 1; o < 64; o <<= 1) { s0 += shx(s0, o, lane); q0 += shx(q0, o, lane); s1 += shx(s1, o, lane); q1 += shx(q1, o, lane); }
    const float m0 = s0 * (1.f / DM), m1 = s1 * (1.f / DM);
    const float r0 = 1.0f / sqrtf(fmaxf(q0 * (1.f / DM) - m0 * m0, 0.f) + LN_EPS), r1 = 1.0f / sqrtf(fmaxf(q1 * (1.f / DM) - m1 * m1, 0.f) + LN_EPS);
#pragma unroll
    for (int j = 0; j < 4; ++j) { const f32x4 gg = ((const f32x4*)g)[64 * j + lane], bb = ((const f32x4*)b)[64 * j + lane]; v0[j] = (v0[j] - m0) * r0 * gg + bb; v1[j] = (v1[j] - m1) * r1 * gg + bb; }
}
template <int N> __device__ __forceinline__ float reduce_lanes(float (&a)[N], int lane) {
    int n = N, mask = 32;
#pragma unroll
    for (; n > 1; n >>= 1, mask >>= 1) {
        const bool up = (lane & mask) != 0;
#pragma unroll
        for (int i = 0; i < n / 2; ++i) { float lo = a[i], hi = a[i + n / 2]; asm volatile("" : "+v"(lo), "+v"(hi));
            const float mine = up ? hi : lo, oth = up ? lo : hi; a[i] = mine + shx(oth, mask, lane); }
    }
    float r = a[0];
#pragma unroll
    for (; mask >= 1; mask >>= 1) r += shx(r, mask, lane);
    return r;
}
struct RowA { const float* PRE; const float* lng; const float* lnb; const float* wr; const float* br; float* X1; bf16_t* X1B; unsigned* cnt; int* rowtok; float* rowgate; int* tokpos; };
__device__ __forceinline__ void phase_row_a(AT_LAS unsigned char* ldsb, const RowA& P, int G, int bx, const int tid) {
    float* part = (float*)(unsigned char*)ldsb;
    int* s_e = (int*)((unsigned char*)ldsb + MISC_OFF + 512);
    float* s_g = (float*)(s_e + 256);
    int* s_rank = (int*)(s_g + 256);
    int* s_cnt = s_rank + 256;
    int* s_base = s_cnt + 32;
    const int lane = tid & 63, wave = tid >> 6;
    if (tid < 32) s_cnt[tid] = 0;
    __syncthreads();
    for (int blk = bx; blk < NTOK / 64; blk += G) {
        const int t0 = blk * 64;
        f32x4 n0[4], n1[4];
#pragma unroll
        for (int j = 0; j < 4; ++j) { n0[j] = ((const f32x4*)(P.PRE + (size_t)(t0 + wave * 8) * DM))[64 * j + lane]; n1[j] = ((const f32x4*)(P.PRE + (size_t)(t0 + wave * 8 + 1) * DM))[64 * j + lane]; }
#pragma unroll 1
        for (int i = 0; i < 8; i += 2) {
            const int row = t0 + wave * 8 + i;
            f32x4 v0[4], v1[4];
#pragma unroll
            for (int j = 0; j < 4; ++j) { v0[j] = n0[j]; v1[j] = n1[j]; }
            if (i + 2 < 8) {
#pragma unroll
                for (int j = 0; j < 4; ++j) { n0[j] = ((const f32x4*)(P.PRE + (size_t)(row + 2) * DM))[64 * j + lane]; n1[j] = ((const f32x4*)(P.PRE + (size_t)(row + 3) * DM))[64 * j + lane]; } }
            ln_rows2(v0, v1, P.lng, P.lnb, lane);
#pragma unroll
            for (int j = 0; j < 4; ++j) { ((f32x4*)(P.X1 + (size_t)row * DM))[64 * j + lane] = v0[j]; ((f32x4*)(P.X1 + (size_t)(row + 1) * DM))[64 * j + lane] = v1[j];
                ((u32x2*)(P.X1B + (size_t)row * DM))[64 * j + lane] = (u32x2){pk2(v0[j].x, v0[j].y), pk2(v0[j].z, v0[j].w)};
                ((u32x2*)(P.X1B + (size_t)(row + 1) * DM))[64 * j + lane] = (u32x2){pk2(v1[j].x, v1[j].y), pk2(v1[j].z, v1[j].w)}; }
        }
        asm volatile("s_waitcnt vmcnt(0)" ::: "memory");
        __syncthreads();
        {
            const int tb = wave >> 2, ks = wave & 3, ti = lane & 31, kh = lane >> 5;
            const float* xr = P.X1 + (size_t)(t0 + 32 * tb + ti) * DM + ks * 256 + 4 * kh;
            const float* wr = P.wr + (size_t)(ks * 256 + 4 * kh) * NEXP + ti;
            at::f32x16 acc = {};
#pragma unroll 4
            for (int c = 0; c < 32; ++c) {
                const f32x4 xa = __builtin_nontemporal_load((const f32x4*)(xr + 8 * c));
                const float w0 = wr[(8 * c + 0) * NEXP], w1 = wr[(8 * c + 1) * NEXP], w2 = wr[(8 * c + 2) * NEXP], w3 = wr[(8 * c + 3) * NEXP];
                acc = __builtin_amdgcn_mfma_f32_32x32x2f32(xa.x, w0, acc, 0, 0, 0); acc = __builtin_amdgcn_mfma_f32_32x32x2f32(xa.y, w1, acc, 0, 0, 0);
                acc = __builtin_amdgcn_mfma_f32_32x32x2f32(xa.z, w2, acc, 0, 0, 0); acc = __builtin_amdgcn_mfma_f32_32x32x2f32(xa.w, w3, acc, 0, 0, 0);
            }
            float* pw = part + wave * (32 * 33);
#pragma unroll
            for (int r = 0; r < 16; ++r) pw[((r & 3) + 8 * (r >> 2) + 4 * kh) * 33 + ti] = acc[r];
        }
        __syncthreads();
        if (tid < 64) {
            const float* p0 = part + ((tid >> 5) * 4) * (32 * 33) + (tid & 31) * 33;
            float lv[NEXP];
#pragma unroll
            for (int e = 0; e < NEXP; ++e) lv[e] = ((p0[e] + p0[32 * 33 + e]) + (p0[2 * 32 * 33 + e] + p0[3 * 32 * 33 + e])) + P.br[e];
            float tv[4]; int ti4[4];
#pragma unroll
            for (int k = 0; k < 4; ++k) { float bv = lv[0]; int bi = 0;
#pragma unroll
                for (int e = 1; e < NEXP; ++e) if (lv[e] > bv) { bv = lv[e]; bi = e; }
                tv[k] = bv; ti4[k] = bi;
#pragma unroll
                for (int e = 0; e < NEXP; ++e) if (e == bi) lv[e] = -INFINITY; }
            const float e1 = __builtin_amdgcn_exp2f(LOG2E * (tv[1] - tv[0])), e2 = __builtin_amdgcn_exp2f(LOG2E * (tv[2] - tv[0])), e3 = __builtin_amdgcn_exp2f(LOG2E * (tv[3] - tv[0])); const float inv = 1.0f / (1.0f + e1 + e2 + e3);
            const int r4 = tid * 4; s_e[r4 + 0] = ti4[0]; s_e[r4 + 1] = ti4[1]; s_e[r4 + 2] = ti4[2]; s_e[r4 + 3] = ti4[3];
            s_g[r4 + 0] = inv; s_g[r4 + 1] = e1 * inv; s_g[r4 + 2] = e2 * inv; s_g[r4 + 3] = e3 * inv;
        }
        __syncthreads();
        if (tid < 256) s_rank[tid] = atomicAdd(&s_cnt[s_e[tid]], 1);
        __syncthreads();
        if (tid < 32) { const int c = s_cnt[tid]; s_base[tid] = c ? (int)atomicAdd(&P.cnt[tid], (unsigned)c) : 0; }
        __syncthreads();
        if (tid < 256) { const int e = s_e[tid], idx = s_base[e] + s_rank[tid], tok = t0 + (tid >> 2);
            P.rowtok[(size_t)e * ECAP + idx] = tok; P.rowgate[(size_t)e * ECAP + idx] = s_g[tid]; P.tokpos[tok * 4 + (tid & 3)] = e * ECAP + idx; }
        if (tid < 32) s_cnt[tid] = 0;
        __syncthreads();
    }
}
struct RowB { const float* X1; const bf16_t* YROWS; const int* tokpos; const unsigned* cnt; const float* lng; const float* lnb; float* X2; bf16_t* X2B; const float* wsh; const float* bfg; float* FLOG; };
template <int MODE> __device__ __forceinline__ void phase_row_b(AT_LAS unsigned char* ldsb, const RowB& P, int G, int bx, const int tid) {
    float* wT = (float*)(unsigned char*)ldsb;
    int* s_pst = (int*)((unsigned char*)ldsb + MISC_OFF);
    const int lane = tid & 63, wave = tid >> 6;
    if (MODE == 0) load_wT(wT, P.wsh, 1548, 1536, NFOX, tid);
    if (tid == 0) { int acc = 0; for (int e = 0; e < NEXP; ++e) { s_pst[e] = acc * 256; acc += ((int)P.cnt[e] + 255) / 256; } }
    float mybias = 0.f; if (MODE == 0) { const int h = lane >> 2; if (h < NFOX) mybias = P.bfg[h]; }
    __syncthreads();
    for (int row = bx * 8 + wave; row < NTOK; row += G * 8) {
        f32x4 v[4];
        const int4 tp4 = *(const int4*)(P.tokpos + row * 4);
        const int tps[4] = {tp4.x, tp4.y, tp4.z, tp4.w};
        u32x2 w[4][4];
#pragma unroll
        for (int k = 0; k < 4; ++k) { const int tp = tps[k]; const int e = tp >> 14, idx = tp & (ECAP - 1); const size_t yr = (size_t)(s_pst[e] + idx);
#pragma unroll
            for (int j = 0; j < 4; ++j) w[k][j] = ((const u32x2*)(P.YROWS + yr * DM))[64 * j + lane]; }
#pragma unroll
        for (int j = 0; j < 4; ++j) v[j] = ((const f32x4*)(P.X1 + (size_t)row * DM))[64 * j + lane] * DN_ALPHA;
#pragma unroll
        for (int k = 0; k < 4; ++k)
#pragma unroll
            for (int j = 0; j < 4; ++j) { v[j].x += __uint_as_float(w[k][j].x << 16); v[j].y += __uint_as_float(w[k][j].x & 0xffff0000u); v[j].z += __uint_as_float(w[k][j].y << 16); v[j].w += __uint_as_float(w[k][j].y & 0xffff0000u); }
        ln_rows(v, P.lng, P.lnb, lane);
#pragma unroll
        for (int j = 0; j < 4; ++j) ((f32x4*)(P.X2 + (size_t)row * DM))[64 * j + lane] = v[j];
        if (MODE == 0) {
#pragma unroll
            for (int j = 0; j < 4; ++j) ((u32x2*)(P.X2B + (size_t)row * DM))[64 * j + lane] = (u32x2){pk2(v[j].x, v[j].y), pk2(v[j].z, v[j].w)};
            float a[16];
#pragma unroll
            for (int e = 0; e < 16; ++e) { float x = 0.f;
                if (e < NFOX) {
#pragma unroll
                    for (int j = 0; j < 4; ++j) { const f32x4 ww = ((const f32x4*)(wT + e * DM))[64 * j + lane]; x += (v[j].x * ww.x + v[j].y * ww.y) + (v[j].z * ww.z + v[j].w * ww.w); } }
                a[e] = x; }
            const float z = reduce_lanes<16>(a, lane) + mybias;
            if ((lane & 3) == 0 && (lane >> 2) < NFOX) { const float ls = fminf(z, 0.f) - 0.6931471805599453f * __builtin_amdgcn_logf(1.0f + __builtin_amdgcn_exp2f(-LOG2E * fabsf(z)));
                const int b = row >> 11, t = row & (SEQ - 1); P.FLOG[(size_t)(b * NFOX + (lane >> 2)) * SEQ + t] = ls; }
        }
    }
}
__device__ __forceinline__ void phase_cumsum(AT_LAS unsigned char* ldsb, const float* FLOG, float* CUM, bf16_t* CKB, int G, int bx, const int tid) {
    float* wsum = (float*)((unsigned char*)ldsb + MISC_OFF + 4096);
    const int lane = tid & 63, wave = tid >> 6;
    for (int q = bx; q < NB * NFOX; q += G) {
        const size_t base = (size_t)q * SEQ;
        const f32x4 x = ((const f32x4*)(FLOG + base))[tid];
        const float a0 = x.x, a1 = a0 + x.y, a2 = a1 + x.z, a3 = a2 + x.w;
        float incl = a3;
#pragma unroll
        for (int o = 1; o < 64; o <<= 1) { const float y = __int_as_float(__builtin_amdgcn_ds_bpermute(((lane - o) & 63) << 2, __float_as_int(incl))); if (lane >= o) incl += y; }
        if (lane == 63) wsum[wave] = incl;
        __syncthreads();
        float off = 0.f; for (int w = 0; w < wave; ++w) off += wsum[w];
        const float ex = off + incl - a3;
        const f32x4 cv = (f32x4){(ex + a0) * LOG2E, (ex + a1) * LOG2E, (ex + a2) * LOG2E, (ex + a3) * LOG2E};
        ((f32x4*)(CUM + base))[tid] = cv;
#pragma unroll
        for (int i = 0; i < 4; ++i) { const float nc = -cv[i]; const unsigned hb = pk2(nc, 0.f) & 0xffffu; const float hf = __uint_as_float(hb << 16); const unsigned lb = pk2(nc - hf, 0.f) & 0xffffu;
            ((u32x4*)(CKB + (base + (size_t)tid * 4 + i) * 8))[0] = (u32x4){0x3F803F80u, hb | (lb << 16), 0u, 0u}; }
        __syncthreads();
    }
}

#define XB_TMO      128
#define XB_XCNT(j)  (256  + 64 * (j))
#define XB_XSUB(j)  (1280 + 64 * (j))
#define XB_XGEN(j)  (2304 + 64 * (j))
#define XB_TOP      3328
#define XB_TOPGEN   3392
#define XCD_BAR_WORDS 3456
#define XB_SPIN_CAP (1u << 18)
__device__ __forceinline__ unsigned xb_ld(unsigned* p)              { return __hip_atomic_load(p, __ATOMIC_RELAXED, __HIP_MEMORY_SCOPE_AGENT); }
__device__ __forceinline__ unsigned xb_add(unsigned* p, unsigned v) { return __hip_atomic_fetch_add(p, v, __ATOMIC_RELAXED, __HIP_MEMORY_SCOPE_AGENT); }
__device__ __forceinline__ unsigned xb_xcc_id() { return (unsigned)__builtin_amdgcn_s_getreg((3 << 11) | 20) & 0xFu; }
#define XB_SPIN(cond, bar) do { unsigned _sp = 0; while (cond) { __builtin_amdgcn_s_sleep(1); \
    if ((++_sp & 255u) == 0u) { if (xb_ld(&(bar)[XB_TMO])) break; if (_sp > XB_SPIN_CAP) { atomicAdd(&(bar)[XB_TMO], 1u); break; } } } } while (0)
struct XcdBarrier { unsigned* bar; unsigned x; volatile AT_LAS unsigned* st; };
__device__ __forceinline__ XcdBarrier xcd_barrier_post(unsigned* bar, volatile AT_LAS unsigned* st, int tid) {
    XcdBarrier b; b.bar = bar; b.x = xb_xcc_id(); b.st = st;
    if (tid == 0) (void)xb_add(&bar[XB_XCNT(b.x)], 1u);
    return b;
}
__device__ __forceinline__ void xcd_barrier_complete(unsigned* bar, unsigned x, unsigned& nloc, unsigned& nx) {
    const unsigned G = gridDim.x * gridDim.y * gridDim.z;
    unsigned sum, cnt, mine, sp = 0u;
    for (;;) {
        sum = 0u; cnt = 0u; mine = 0u;
#pragma unroll
        for (unsigned j = 0; j < 16; ++j) { const unsigned c = xb_ld(&bar[XB_XCNT(j)]); sum += c; cnt += (c > 0u) ? 1u : 0u; mine = (j == x) ? c : mine; }
        if (sum == G) break;
        __builtin_amdgcn_s_sleep(1);
        if ((++sp & 255u) == 0u) { if (xb_ld(&bar[XB_TMO])) break; if (sp > XB_SPIN_CAP) { atomicAdd(&bar[XB_TMO], 1u); break; } }
    }
    nloc = mine > 0u ? mine : 1u; nx = cnt > 0u ? cnt : 1u;
}
__device__ __forceinline__ void xcd_barrier(const XcdBarrier& b, int tid) {
    asm volatile("s_waitcnt vmcnt(0)" ::: "memory");
    __syncthreads();
    if (tid == 0) {
        unsigned* bar = b.bar; asm volatile("" : "+s"(bar));
        __builtin_amdgcn_s_waitcnt(0);
        unsigned nloc = b.st[0], nx = b.st[1];
        if (nloc == 0u) { xcd_barrier_complete(bar, b.x, nloc, nx); b.st[0] = nloc; b.st[1] = nx; }
        const unsigned old = xb_add(&bar[XB_XSUB(b.x)], 1u);
        const unsigned gen = old / nloc;
        if (old + 1u == (gen + 1u) * nloc) {
            __builtin_amdgcn_fence(__ATOMIC_RELEASE, "agent");
            asm volatile("s_waitcnt vmcnt(0)" ::: "memory");
            const unsigned og = xb_add(&bar[XB_TOP], 1u);
            const unsigned tg = og / nx;
            if (og + 1u == (tg + 1u) * nx) xb_add(&bar[XB_TOPGEN], 1u);
            else XB_SPIN(xb_ld(&bar[XB_TOPGEN]) == tg, bar);
            __builtin_amdgcn_fence(__ATOMIC_ACQUIRE, "agent");
            xb_add(&bar[XB_XGEN(b.x)], 1u);
            asm volatile("s_waitcnt vmcnt(0)" ::: "memory");
        } else {
            XB_SPIN(xb_ld(&bar[XB_XGEN(b.x)]) == gen, bar);
            __builtin_amdgcn_fence(__ATOMIC_ACQUIRE, "agent");
            asm volatile("s_waitcnt vmcnt(0)" ::: "memory");
        }
    }
    __syncthreads();
}

struct TrJob { const float* W; int ldw, K, Np; bf16_t* WT; int nmat; size_t sstride, dstride; };
template <int MAP> __device__ __forceinline__ void tr_job(const TrJob& j, float* scr, int gw, int NGW, int lane) {
    const int nblk = j.Np / 32, per = (j.K / 64) * nblk; const long total = (long)per * j.nmat;
    for (long it = gw; it < total; it += NGW) { const int mat = (int)(it / per), item = (int)(it % per);
        transpose_item<MAP>(j.W + mat * j.sstride, j.ldw, 0, j.K, j.WT + mat * j.dstride, item, nblk, scr, lane); }
}
__device__ __forceinline__ void cvt_rows(const float* src, bf16_t* dst, size_t n8, size_t gt, size_t NGT) {
    for (size_t i = gt; i < n8; i += NGT) { const f32x4 a = ((const f32x4*)src)[2 * i], b = ((const f32x4*)src)[2 * i + 1];
        u32x4 o; o.x = pk2(a.x, a.y); o.y = pk2(a.z, a.w); o.z = pk2(b.x, b.y); o.w = pk2(b.z, b.w); ((u32x4*)dst)[i] = o; }
}

constexpr unsigned STEAL_D0 = 32u * 512u, STEAL_GU = STEAL_D0 + 32u * 1024u, STEAL_TOTAL = STEAL_GU + 32u * 512u;
constexpr int CW_QNEXT = 512, CW_DONE = 576;
__device__ __forceinline__ void steal_convert(AT_LAS unsigned char* lds, unsigned char* lds_gen, const float* w_gu, const float* w_dn, bf16_t* WT_GU, bf16_t* WT_DN, unsigned* qnext, unsigned* done, unsigned limit, int G, int tid) {
    const int lane = tid & 63, wave = __builtin_amdgcn_readfirstlane(tid >> 6);
    float* scr = (float*)lds_gen + wave * 64 * 33;
    volatile AT_LAS unsigned* slot = (volatile AT_LAS unsigned*)(lds + MISC_OFF + 384);
    __syncthreads();
    if (done && tid == 0) __hip_atomic_fetch_add(done, 1u, __ATOMIC_RELAXED, __HIP_MEMORY_SCOPE_AGENT);
    for (;;) {
        if (tid == 0) { unsigned it = 0xFFFFFFFFu;
            const bool alldone = !done || __hip_atomic_load(done, __ATOMIC_RELAXED, __HIP_MEMORY_SCOPE_AGENT) >= (unsigned)G;
            const bool stop = alldone && __hip_atomic_load(qnext, __ATOMIC_RELAXED, __HIP_MEMORY_SCOPE_AGENT) >= limit;
            if (!stop) it = __hip_atomic_fetch_add(qnext, 8u, __ATOMIC_RELAXED, __HIP_MEMORY_SCOPE_AGENT);
            *slot = it; }
        __syncthreads();
        const unsigned it0 = *slot;
        __syncthreads();
        if (it0 >= STEAL_TOTAL) break;
        const unsigned it = it0 + (unsigned)wave;
        if (it < STEAL_D0) { const int mat = (int)(it >> 9), item = (int)(it & 511);
            transpose_item<0>(w_dn + (size_t)mat * DFF * DM, DM, 0, DFF, WT_DN + (size_t)mat * DM * DFF, item, 32, scr, lane); }
        else if (it < STEAL_GU) { const unsigned r = it - STEAL_D0; const int mat = (int)(r >> 10), item = (int)(r & 1023);
            transpose_item<2>(w_gu + (size_t)(32 + mat) * DM * 2048, 2048, 0, DM, WT_GU + (size_t)(32 + mat) * 2048 * DM, item, 64, scr, lane); }
        else if (it < STEAL_TOTAL) { const unsigned r = it - STEAL_GU; const int mat = (int)(r >> 9), item = (int)(r & 511);
            transpose_item<0>(w_dn + (size_t)(32 + mat) * DFF * DM, DM, 0, DFF, WT_DN + (size_t)(32 + mat) * DM * DFF, item, 32, scr, lane); }
    }
}

constexpr int CW_BAR = 4096;
constexpr int NPHASE = 15;
#ifndef PROBE_MASK
#define PROBE_MASK 0
#endif
struct MegaArgs { const float* in[19]; float* out; unsigned char* ws; int ph_lo, ph_hi; };
__device__ __forceinline__ int lane_id_volatile() { int l; asm volatile("v_mbcnt_lo_u32_b32 %0, -1, 0\n\tv_mbcnt_hi_u32_b32 %0, -1, %0" : "=v"(l)); return l; }
#define OPQ_S(x) asm volatile("" : "+s"(x))
#define OPQ_V(x) asm volatile("" : "+v"(x))
__global__ void __launch_bounds__(512, 2) k_mega(MegaArgs a) {
    extern __shared__ __attribute__((aligned(16))) unsigned char lds_raw[];
    AT_LAS unsigned char* lds = (AT_LAS unsigned char*)lds_raw;
    { const int t0 = threadIdx.x; for (int u = t0; u < (FAST_LDS - MISC_OFF) / 4; u += 512) ((AT_LAS unsigned*)(lds + MISC_OFF))[u] = 0u; }
    __syncthreads();
    const int lo = a.ph_lo, hi = a.ph_hi;
    const int wave_s = __builtin_amdgcn_readfirstlane(threadIdx.x >> 6);
    XcdBarrier bar; bar.bar = (unsigned*)(a.ws + WS_CTL) + CW_BAR; bar.x = 0; bar.st = (volatile AT_LAS unsigned*)(lds + MISC_OFF + 256);
    if (hi - lo > 1) bar = xcd_barrier_post((unsigned*)(a.ws + WS_CTL) + CW_BAR, (volatile AT_LAS unsigned*)(lds + MISC_OFF + 256), threadIdx.x);
#define PH_ENTER \
        int tid = wave_s * 64 + lane_id_volatile(); OPQ_V(tid); const __attribute__((address_space(4))) MegaArgs* ap = (const __attribute__((address_space(4))) MegaArgs*)__builtin_amdgcn_kernarg_segment_ptr(); OPQ_S(ap); unsigned char* ws = ap->ws; int G = gridDim.x, bx = blockIdx.x; OPQ_S(G); OPQ_S(bx); const int vcu = vcu_of(bx, G); (void)vcu; \
        const int l = (ph >= 8) ? 1 : 0; unsigned* cnt = (unsigned*)(ws + WS_CTL) + CW_CNT + l * 64; (void)cnt; AT_LAS int* pre = (AT_LAS int*)(lds + MISC_OFF); (void)pre;
#define P_BF(off) ((bf16_t*)(ws + (off)))
#define P_F32(off) ((float*)(ws + (off)))
#define STEAL(k, lim) steal_convert(lds, lds_raw, ap->in[15], ap->in[17], P_BF(WS_WT_GU), P_BF(WS_WT_DN), (unsigned*)(ws + WS_CTL) + CW_QNEXT, (k) < 0 ? nullptr : (unsigned*)(ws + WS_CTL) + CW_DONE + 64 * (k), (lim), G, tid)
#pragma unroll 1
    for (int r0 = 0; r0 < ((lo == 0) ? 1 + (PROBE_MASK & 1) : 0); ++r0) { const int ph = 0; PH_ENTER
            const int lane = tid & 63, wave = __builtin_amdgcn_readfirstlane(tid >> 6);
            float* scr = (float*)lds_raw + wave * 64 * 33;
            const int gw = vcu * 8 + wave, NGW = G * 8;
#define GW_AT(off) ((gw + NGW - ((off) % NGW)) % NGW)
            tr_job<1>(TrJob{ap->in[2], A_IN, DM, A_IN, P_BF(WS_WT_INA), 1, 0, 0}, scr, GW_AT(0), NGW, lane);
            tr_job<0>(TrJob{ap->in[6], 1548, DM, 1536, P_BF(WS_WT_INB), 1, 0, 0}, scr, GW_AT(1280), NGW, lane);
            tr_job<0>(TrJob{ap->in[4], 1024, DM, 1024, P_BF(WS_WT_INB) + (size_t)1536 * DM, 1, 0, 0}, scr, GW_AT(2048), NGW, lane);
            tr_job<0>(TrJob{ap->in[3], DM, A_OUT, DM, P_BF(WS_WT_OUTA), 1, 0, 0}, scr, GW_AT(2560), NGW, lane);
            tr_job<0>(TrJob{ap->in[5], DM, B_OUT, DM, P_BF(WS_WT_OUTB), 1, 0, 0}, scr, GW_AT(2816), NGW, lane);
            tr_job<0>(TrJob{ap->in[8], 512, DM, 512, P_BF(WS_WT_MKV), 2, (size_t)DM * 512, (size_t)512 * DM}, scr, GW_AT(3328), NGW, lane);
            tr_job<2>(TrJob{ap->in[15], 2048, DM, 2048, P_BF(WS_WT_GU), 32, (size_t)DM * 2048, (size_t)2048 * DM}, scr, GW_AT(3840), NGW, lane);
#undef GW_AT
            const size_t gt = (size_t)vcu * 512 + tid, NGT = (size_t)G * 512;
            cvt_rows(ap->in[0], P_BF(WS_XB), (size_t)NTOK * DM / 8, gt, NGT);
            cvt_rows(ap->in[1], P_BF(WS_MEMB), (size_t)NMEMROW * DM / 8, gt, NGT);
        if (hi > 1) xcd_barrier(bar, tid);
    }
#pragma unroll 1
    for (int pp = 2 * (lo < 1 ? 1 : lo); pp < 2 * hi; ++pp) {
        const int ph = pp >> 1;
        if ((pp & 1) && !((PROBE_MASK >> ph) & 1)) continue;
        switch (ph) {
        case 1: { PH_ENTER
            const bf16_t* WT_MKV = P_BF(WS_WT_MKV); const bf16_t* MEMB = P_BF(WS_MEMB); bf16_t* MEMKV = P_BF(WS_MEMKV);
            { fg::DenseSched S; S.init(P_BF(WS_WT_INA), NTOK, A_IN, DM, G, bx); fg::gemm_phase<0>(lds, P_BF(WS_XB), DM, S, EpiInA{P_BF(WS_QKV)}, tid); }
            { fg::DenseSched S; S.init(WT_MKV, NMEMROW, 512, DM, G, (bx + G / 2) % G); fg::gemm_phase<0>(lds, MEMB, DM, S, EpiPlain{MEMKV, 512, 0}, tid); }
            { fg::DenseSched S; S.init(WT_MKV + (size_t)512 * DM, NMEMROW, 512, DM, G, (bx + G / 2 + G - 16) % G); fg::gemm_phase<0>(lds, MEMB, DM, S, EpiPlain{MEMKV + (size_t)NMEMROW * 512, 512, 0}, tid); }
            STEAL(0, 0u);
        } break;
        case 2: { PH_ENTER phase_attn_a((AT_LAS char*)lds, P_BF(WS_QKV), P_BF(WS_MEMKV), P_BF(WS_MERGED), G, vcu, tid); } break;
        case 3: { PH_ENTER fg::DenseSched S; S.init(P_BF(WS_WT_OUTA), NTOK, DM, A_OUT, G, bx); fg::gemm_phase<0>(lds, P_BF(WS_MERGED), A_OUT, S, EpiOut{P_F32(WS_PRE), ap->in[0]}, tid); } break;
        case 4: case 11: { PH_ENTER
            if (l == 1) STEAL(-1, STEAL_GU);
            phase_row_a(lds, RowA{P_F32(WS_PRE), ap->in[9] + l * DM, ap->in[10] + l * DM, ap->in[13] + (size_t)l * DM * NEXP, ap->in[14] + l * NEXP, P_F32(WS_X1), P_BF(WS_X1B), cnt,
                                  (int*)(ws + WS_ROWTOK), P_F32(WS_ROWGATE), (int*)(ws + WS_TOKPOS)}, G, bx, tid); } break;
        case 5: case 12: { PH_ENTER fg::moe_prefix(cnt, pre, 8, tid); fg::MoeSched<1> S{P_BF(WS_WT_GU) + (size_t)l * 32 * 2048 * DM, cnt, (const int*)(ws + WS_ROWTOK), pre, G, vcu};
            fg::gemm_phase<1>(lds, P_BF(WS_X1B), DM, S, EpiGU{P_BF(WS_ACT), ap->in[16] + (size_t)l * 32 * 2048}, tid);
            if (l == 0) STEAL(1, STEAL_D0); else STEAL(4, STEAL_TOTAL); } break;
        case 6: case 13: { PH_ENTER fg::moe_prefix(cnt, pre, 4, tid); fg::MoeSched<0> S{P_BF(WS_WT_DN) + (size_t)l * 32 * DM * DFF, cnt, nullptr, pre, G, vcu};
            fg::gemm_phase<0>(lds, P_BF(WS_ACT), DFF, S, EpiDN{P_BF(WS_YROWS), ap->in[18] + (size_t)l * 32 * DM, P_F32(WS_ROWGATE)}, tid); if (l == 0) STEAL(2, 0u); } break;
        case 7: { PH_ENTER phase_row_b<0>(lds, RowB{P_F32(WS_X1), P_BF(WS_YROWS), (const int*)(ws + WS_TOKPOS), cnt, ap->in[11], ap->in[12], P_F32(WS_X2), P_BF(WS_XB), ap->in[6], ap->in[7], P_F32(WS_FLOG)}, G, bx, tid); } break;
        case 8: { PH_ENTER phase_cumsum(lds, P_F32(WS_FLOG), P_F32(WS_CUM), P_BF(WS_CKB), G, (bx + G / 2) % G, tid);
            fg::DenseSched S; S.init(P_BF(WS_WT_INB), NTOK, B_IN, DM, G, bx); fg::gemm_phase<0>(lds, P_BF(WS_XB), DM, S, EpiInB{P_BF(WS_QKV)}, tid); STEAL(3, 0u); } break;
        case 9: { PH_ENTER phase_attn_b((AT_LAS char*)lds, P_BF(WS_QKV), P_F32(WS_CUM), P_BF(WS_CKB), P_BF(WS_MEMKV) + (size_t)NMEMROW * 512, P_BF(WS_MERGED), G, vcu, tid); } break;
        case 10: { PH_ENTER fg::DenseSched S; S.init(P_BF(WS_WT_OUTB), NTOK, DM, B_OUT, G, bx); fg::gemm_phase<0>(lds, P_BF(WS_MERGED), B_OUT, S, EpiOut{P_F32(WS_PRE), P_F32(WS_X2)}, tid); } break;
        case 14: { PH_ENTER phase_row_b<1>(lds, RowB{P_F32(WS_X1), P_BF(WS_YROWS), (const int*)(ws + WS_TOKPOS), cnt, ap->in[11] + DM, ap->in[12] + DM, ap->out, nullptr, nullptr, nullptr, nullptr}, G, bx, tid); } break;
        default: break;
        }
#undef PH_ENTER
        if (pp + 1 < 2 * hi) { int tb = wave_s * 64 + lane_id_volatile(); OPQ_V(tb); xcd_barrier(bar, tb);
#if defined(PROBE_BAR)
            xcd_barrier(bar, tb);
#endif
        }
    }
}

#ifndef N_LAUNCHES
#define N_LAUNCHES 1
#endif
extern "C" void kernel_launch(void* const* d_in, const int* in_sizes, int n_in, void* d_out, int out_size, void* d_ws, size_t ws_size, hipStream_t stream) {
    static int grid = 0;
    if (grid == 0) {
        if (n_in != 19 || out_size != NTOK * DM || ws_size < WS_END) { fprintf(stderr, "kernel_launch: unexpected shapes (n_in %d out %d ws %zu)\n", n_in, out_size, ws_size); grid = -1; return; }
        int dev = 0, cus = 0;
        if (hipGetDevice(&dev) != hipSuccess || hipDeviceGetAttribute(&cus, hipDeviceAttributeMultiprocessorCount, dev) != hipSuccess || cus <= 0) { fprintf(stderr, "kernel_launch: device query failed\n"); grid = -1; return; }
        if (hipFuncSetAttribute((const void*)k_mega, hipFuncAttributeMaxDynamicSharedMemorySize, FAST_LDS) != hipSuccess) { fprintf(stderr, "kernel_launch: hipFuncSetAttribute failed\n"); grid = -1; return; }
        grid = cus;
    }
    if (grid < 0) return;
    (void)hipMemsetAsync((char*)d_ws + WS_CTL, 0, 1 * MiB, stream);
    MegaArgs a{};
    for (int i = 0; i < 19; ++i) a.in[i] = (const float*)d_in[i];
    a.out = (float*)d_out; a.ws = (unsigned char*)d_ws;
    if (N_LAUNCHES == 1) { a.ph_lo = 0; a.ph_hi = NPHASE; hipLaunchKernelGGL(k_mega, dim3(grid), dim3(512), FAST_LDS, stream, a); }
    else for (int p = 0; p < NPHASE; ++p) { a.ph_lo = p; a.ph_hi = p + 1; hipLaunchKernelGGL(k_mega, dim3(grid), dim3(512), FAST_LDS, stream, a); }
}
```

```cpp
#include <hip/hip_runtime.h>
#include <cstdio>
#include <cstdint>

typedef unsigned short bf16_t;
typedef float f32x4 __attribute__((ext_vector_type(4)));
typedef float f32x2 __attribute__((ext_vector_type(2)));
typedef unsigned u32x4 __attribute__((ext_vector_type(4)));
typedef unsigned u32x2 __attribute__((ext_vector_type(2)));

constexpr int DM = 1024, NB = 8, SEQ = 2048, NTOK = NB * SEQ, HD = 64;
constexpr int MEM_LEN = 256, NMEMROW = NB * MEM_LEN;
constexpr int A_IN = 2560, A_OUT = 512, B_IN = 2560  , B_OUT = 1024;
constexpr int NEXP = 32, TOPK = 4, DFF = 1024, ECAP = NTOK;
constexpr int NFOX = 12;
constexpr int MAXROWS = 73728;
constexpr size_t LA_K = (size_t)3 * 8 * 4 * 2048 * 64, LA_QM = 3 * LA_K;
constexpr size_t LB_V = (size_t)768 * 16384, LB_QF = 2 * LB_V, LB_QM = 3 * LB_V;
constexpr float LN_EPS = 1e-5f;
constexpr float DN_ALPHA = 1.4142135623730951f;
constexpr float C2 = 0.125f * 1.4426950408889634f;
constexpr float LOG2E = 1.4426950408889634f;
constexpr float SW_LIMIT = 7.0f, SW_ALPHA = 1.702f;

constexpr size_t MiB = 1ull << 20;
constexpr size_t WS_CTL = 0;
constexpr size_t WS_ROPE = 1 * MiB;
constexpr size_t WS_CUM = 2 * MiB;
constexpr size_t WS_FLOG = 3 * MiB;
constexpr size_t WS_ROWTOK = 4 * MiB;
constexpr size_t WS_ROWGATE = 6 * MiB;
constexpr size_t WS_TOKPOS = 8 * MiB;
constexpr size_t WS_MEMB = 10 * MiB;
constexpr size_t WS_MEMKV = 14 * MiB;
constexpr size_t WS_WT_INA = 18 * MiB;
constexpr size_t WS_WT_INB = 23 * MiB;
constexpr size_t WS_WT_OUTA = 28 * MiB;
constexpr size_t WS_WT_OUTB = 29 * MiB;
constexpr size_t WS_WT_MKV = 31 * MiB;
constexpr size_t WS_XB = 34 * MiB;
constexpr size_t WS_X1B = 66 * MiB;
constexpr size_t WS_QKV = 98 * MiB;
constexpr size_t WS_MERGED = 178 * MiB;
constexpr size_t WS_PRE = 210 * MiB;
constexpr size_t WS_X1 = 274 * MiB;
constexpr size_t WS_X2 = 338 * MiB;
constexpr size_t WS_ACT = 402 * MiB;
constexpr size_t WS_YROWS = 546 * MiB;
constexpr size_t WS_WT_GU = 690 * MiB;
constexpr size_t WS_WT_DN = 946 * MiB;
constexpr size_t WS_CKB = 1074 * MiB;
constexpr size_t WS_END = 1078 * MiB;
constexpr int CW_CNT = 64;

__device__ __forceinline__ float bf2f(bf16_t v) { return __uint_as_float((unsigned)v << 16); }
__device__ __forceinline__ unsigned f2bf(float f) { unsigned u = __float_as_uint(f); return (u + 0x7fffu + ((u >> 16) & 1u)) >> 16; }
typedef __bf16 hwbf16x2_t __attribute__((ext_vector_type(2)));
__device__ __forceinline__ unsigned pk2(float lo, float hi) { f32x2 v = {lo, hi}; hwbf16x2_t b = __builtin_convertvector(v, hwbf16x2_t); return __builtin_bit_cast(unsigned, b); }
__device__ __forceinline__ void unpack8(const u32x4 w, float* f) {
    f[0] = __uint_as_float(w.x << 16); f[1] = __uint_as_float(w.x & 0xffff0000u);
    f[2] = __uint_as_float(w.y << 16); f[3] = __uint_as_float(w.y & 0xffff0000u);
    f[4] = __uint_as_float(w.z << 16); f[5] = __uint_as_float(w.z & 0xffff0000u);
    f[6] = __uint_as_float(w.w << 16); f[7] = __uint_as_float(w.w & 0xffff0000u);
}
__device__ __forceinline__ float shx(float v, int mask, int lane) { return __int_as_float(__builtin_amdgcn_ds_bpermute((lane ^ mask) << 2, __float_as_int(v))); }

__constant__ double c_invfreq[32] = {1.0, 0.7498942093324559, 0.5623413251903491, 0.4216965034285822, 0.31622776601683794, 0.23713737056616552, 0.1778279410038923, 0.1333521432163324, 0.1, 0.07498942093324558, 0.05623413251903491, 0.042169650342858224, 0.03162277660168379, 0.023713737056616554, 0.01778279410038923, 0.01333521432163324, 0.01, 0.007498942093324558, 0.005623413251903491, 0.004216965034285823, 0.0031622776601683794, 0.0023713737056616554, 0.0017782794100389228, 0.001333521432163324, 0.001, 0.0007498942093324559, 0.0005623413251903491, 0.00042169650342858224, 0.00031622776601683794, 0.00023713737056616554, 0.00017782794100389227, 0.0001333521432163324};

__device__ __forceinline__ void sincos_d(double a, float& s, float& c) {
    const double n = rint(a * 0.15915494309189535);
    double r = fma(-n, 6.283185307179586, a);
    r = fma(-n, 2.4492935982947064e-16, r);
    const double h = 0.5 * r, h2 = h * h;
    double sp = 1.0 / 355687428096000.0;
    sp = fma(sp, h2, -1.0 / 1307674368000.0); sp = fma(sp, h2, 1.0 / 6227020800.0); sp = fma(sp, h2, -1.0 / 39916800.0);
    sp = fma(sp, h2, 1.0 / 362880.0); sp = fma(sp, h2, -1.0 / 5040.0); sp = fma(sp, h2, 1.0 / 120.0); sp = fma(sp, h2, -1.0 / 6.0); sp = fma(sp, h2, 1.0);
    const double sh = sp * h;
    double cp = 1.0 / 20922789888000.0;
    cp = fma(cp, h2, -1.0 / 87178291200.0); cp = fma(cp, h2, 1.0 / 479001600.0); cp = fma(cp, h2, -1.0 / 3628800.0);
    cp = fma(cp, h2, 1.0 / 40320.0); cp = fma(cp, h2, -1.0 / 720.0); cp = fma(cp, h2, 1.0 / 24.0); cp = fma(cp, h2, -0.5); cp = fma(cp, h2, 1.0);
    s = (float)(2.0 * sh * cp); c = (float)(1.0 - 2.0 * sh * sh);
}

template <int MAP> __device__ __forceinline__ int colmap(int p) {
    if (MAP == 1) {
        if (p >= 2304) return p;
        const int rem = p % 768, part = rem >> 8;
        if (part == 2) return p;
        const int dd = p & 63, d = (dd & 1) ? (dd >> 1) + 32 : (dd >> 1);
        return (p & ~63) + d;
    } else if (MAP == 2) {
        return ((p & 255) >> 7) * 1024 + (p >> 8) * 128 + (p & 127);
    }
    return p;
}
template <int MAP> __device__ __forceinline__ void transpose_item(const float* __restrict__ W, int ldw, int coloff, int K, bf16_t* __restrict__ WT, int item, int nblk, float* scr, int lane) {
    const int kb = item / nblk, nb = item % nblk, k0 = 64 * kb, n0 = 32 * nb;
    if (MAP == 1) {
        const int srcc = coloff + colmap<MAP>(n0 + (lane & 31));
#pragma unroll 8
        for (int i = 0; i < 32; ++i) { const int kk = 2 * i + (lane >> 5); scr[kk * 33 + (lane & 31)] = W[(size_t)(k0 + kk) * ldw + srcc]; }
    } else {
        const int c4 = (lane & 7) * 4, srcc = coloff + colmap<MAP>(n0 + c4);
        f32x4 v[8];
#pragma unroll
        for (int i = 0; i < 8; ++i) v[i] = __builtin_nontemporal_load((const f32x4*)(W + (size_t)(k0 + 8 * i + (lane >> 3)) * ldw + srcc));
#pragma unroll
        for (int i = 0; i < 8; ++i) { float* d = scr + (8 * i + (lane >> 3)) * 33 + c4; d[0] = v[i].x; d[1] = v[i].y; d[2] = v[i].z; d[3] = v[i].w; }
    }
    asm volatile("s_waitcnt lgkmcnt(0)" ::: "memory");
    const int c = lane & 7;
#pragma unroll
    for (int j = 0; j < 4; ++j) { const int n = (lane >> 3) + 8 * j; const float* s = scr + (8 * c) * 33 + n;
        u32x4 o; o.x = pk2(s[0 * 33], s[1 * 33]); o.y = pk2(s[2 * 33], s[3 * 33]); o.z = pk2(s[4 * 33], s[5 * 33]); o.w = pk2(s[6 * 33], s[7 * 33]);
        __builtin_nontemporal_store(o, (u32x4*)(WT + (size_t)(n0 + n) * K + k0 + 8 * c)); }
    asm volatile("s_waitcnt lgkmcnt(0)" ::: "memory");
}
#define EPI_ROW(ai, m) ((ai) * 128 + wr * 64 + (m) * 16 + fr)
#define EPI_COL(bj, n) ((bj) * 128 + wc * 32 + (n) * 16 + 4 * fq)
#define EPI_COLP(bj) ((bj) * 128 + wc * 32 + 8 * fq)
__device__ __forceinline__ u32x4 pk8(const f32x4 a, const f32x4 b) { return (u32x4){pk2(a.x, a.y), pk2(a.z, a.w), pk2(b.x, b.y), pk2(b.z, b.w)}; }
#define EPI_XROW (lane_ >> 2)
#define EPI_XCOL (8 * (lane_ & 3))
__device__ __forceinline__ u32x4 epi_xpose(__attribute__((address_space(3))) unsigned char* xb, const u32x4 v, int fr, int fq, int lane_) {
    *(__attribute__((address_space(3))) u32x4*)(xb + fr * 80 + fq * 16) = v;
    return *(const __attribute__((address_space(3))) u32x4*)(xb + (lane_ >> 2) * 80 + (lane_ & 3) * 16);
}
struct EpiInA { bf16_t* out;
    static constexpr bool PERM = true;
    template <class U> __device__ __forceinline__ void tile(const U& u, const f32x4 (&acc)[2][2][4][2], int wr, int wc, int fr, int fq, __attribute__((address_space(3))) unsigned char* xb) const {
        const int lane_ = fq * 16 + fr; (void)lane_;
#pragma unroll
        for (int bj = 0; bj < 2; ++bj) {
            const int p = u.col0 + EPI_COLP(bj); const int part = (p < 2304) ? ((p % 768) >> 8) : 3;
            const int j0 = (p & 63) >> 1; float f[4];
#pragma unroll
            for (int i = 0; i < 4; ++i) f[i] = __builtin_amdgcn_exp2f(-(float)(j0 + i) * 0.41524101186092034f) * 0.15915494309189535f;
#pragma unroll
            for (int ai = 0; ai < 2; ++ai)
#pragma unroll
                for (int m = 0; m < 4; ++m) { const int row = u.row0 + EPI_ROW(ai, m); f32x4 v[2] = {acc[ai][bj][m][0], acc[ai][bj][m][1]};
                    if (part < 2) { const float pos = (float)(row & (SEQ - 1));
#pragma unroll
                        for (int n = 0; n < 2; ++n) { const float t0 = __builtin_amdgcn_fractf(pos * f[2 * n]), t1 = __builtin_amdgcn_fractf(pos * f[2 * n + 1]);
                            const float c0 = __builtin_amdgcn_cosf(t0), s0 = __builtin_amdgcn_sinf(t0), c1 = __builtin_amdgcn_cosf(t1), s1 = __builtin_amdgcn_sinf(t1);
                            f32x4 o; o.x = v[n].x * c0 - v[n].y * s0; o.y = v[n].y * c0 + v[n].x * s0; o.z = v[n].z * c1 - v[n].w * s1; o.w = v[n].w * c1 + v[n].z * s1; v[n] = o; } }
                    if (part == 0 || part == 3) { v[0] = v[0] * C2; v[1] = v[1] * C2; }
                    const u32x4 vx = epi_xpose(xb, pk8(v[0], v[1]), fr, fq, lane_);
                    const int px = u.col0 + bj * 128 + wc * 32 + EPI_XCOL, rowx = row - fr + EPI_XROW;
                    const int bb = rowx >> 11, t = rowx & (SEQ - 1); size_t off;
                    if (part == 3) off = LA_QM + ((size_t)((bb * 4 + ((px - 2304) >> 6)) * SEQ + t) << 6) + (px & 63);
                    else { const int g = px / 768, hh = ((px - g * 768) >> 6) & 3, dsh = 2 * g, gb = (g * 8 + bb) * 4 + hh;
                        if (part == 0) off = ((size_t)((gb * 16 + (t & 15)) * 128 + (t >> 4)) << 6) + (px & 63);
                        else off = LA_K * part + ((size_t)(gb * SEQ + (t & ((1 << dsh) - 1)) * (SEQ >> dsh) + (t >> dsh)) << 6) + (px & 63); }
                    *(u32x4*)(out + off) = vx; }
        }
    } };
struct EpiInB { bf16_t* out;
    static constexpr bool PERM = true;
    template <class U> __device__ __forceinline__ void tile(const U& u, const f32x4 (&acc)[2][2][4][2], int wr, int wc, int fr, int fq, __attribute__((address_space(3))) unsigned char* xb) const {
        const int lane_ = fq * 16 + fr; (void)lane_;
#pragma unroll
        for (int ai = 0; ai < 2; ++ai)
#pragma unroll
            for (int m = 0; m < 4; ++m) { const int row = u.row0 + EPI_ROW(ai, m);
#pragma unroll
                for (int bj = 0; bj < 2; ++bj) { const int p0 = u.col0 + EPI_COLP(bj); const float sc = (p0 >= 1536) ? C2 : 1.0f;
                    const u32x4 v = epi_xpose(xb, pk8(acc[ai][bj][m][0] * sc, acc[ai][bj][m][1] * sc), fr, fq, lane_);
                    const int p = u.col0 + bj * 128 + wc * 32 + EPI_XCOL, rowx = row - fr + EPI_XROW;
                    const int reg = p >= 2304 ? 3 : p / 768, pc = p - reg * 768, nh = reg == 3 ? 4 : NFOX, bb = rowx >> 11, t = rowx & (SEQ - 1);
                    *(u32x4*)(out + (size_t)reg * LB_V + ((size_t)((bb * nh + (pc >> 6)) * SEQ + t) << 6) + (pc & 63)) = v; } }
    } };
struct EpiPlain { bf16_t* out; int ld; int pad;
    static constexpr bool PERM = true;
    template <class U> __device__ __forceinline__ void tile(const U& u, const f32x4 (&acc)[2][2][4][2], int wr, int wc, int fr, int fq, __attribute__((address_space(3))) unsigned char* xb) const {
        const int lane_ = fq * 16 + fr; (void)lane_;
#pragma unroll
        for (int ai = 0; ai < 2; ++ai)
#pragma unroll
            for (int m = 0; m < 4; ++m) { const int row = u.row0 + EPI_ROW(ai, m);
#pragma unroll
                for (int bj = 0; bj < 2; ++bj) *(u32x4*)(out + (size_t)(row - fr + EPI_XROW) * ld + u.col0 + bj * 128 + wc * 32 + EPI_XCOL) = epi_xpose(xb, pk8(acc[ai][bj][m][0], acc[ai][bj][m][1]), fr, fq, lane_); }
    } };
struct EpiOut { float* pre; const float* res;
    static constexpr bool PERM = false;
    template <class U> __device__ __forceinline__ void tile(const U& u, const f32x4 (&acc)[2][2][4][2], int wr, int wc, int fr, int fq, __attribute__((address_space(3))) unsigned char* xb) const {
        const int lane_ = fq * 16 + fr; (void)lane_;
#pragma unroll
        for (int ai = 0; ai < 2; ++ai) {
            f32x4 x[4][2][2];
#pragma unroll
            for (int m = 0; m < 4; ++m)
#pragma unroll
                for (int bj = 0; bj < 2; ++bj)
#pragma unroll
                    for (int n = 0; n < 2; ++n) x[m][bj][n] = *(const f32x4*)(res + (size_t)(u.row0 + ai * 128 + wr * 64 + m * 16 + EPI_XROW) * DM + u.col0 + bj * 128 + wc * 32 + n * 16 + 4 * (lane_ & 3));
#pragma unroll
            for (int m = 0; m < 4; ++m)
#pragma unroll
                for (int bj = 0; bj < 2; ++bj)
#pragma unroll
                    for (int n = 0; n < 2; ++n) { const f32x4 at = __builtin_bit_cast(f32x4, epi_xpose(xb, __builtin_bit_cast(u32x4, acc[ai][bj][m][n]), fr, fq, lane_));
                        *(f32x4*)(pre + (size_t)(u.row0 + ai * 128 + wr * 64 + m * 16 + EPI_XROW) * DM + u.col0 + bj * 128 + wc * 32 + n * 16 + 4 * (lane_ & 3)) = x[m][bj][n] * DN_ALPHA + at; }
        }
    } };
struct EpiGU { bf16_t* act; const float* bgu;
    static constexpr bool PERM = true;
    template <class U> __device__ __forceinline__ void tile(const U& u, const f32x4 (&acc)[2][2][4][2], int wr, int wc, int fr, int fq, __attribute__((address_space(3))) unsigned char* xb) const {
        const int lane_ = fq * 16 + fr; (void)lane_;
        f32x4 bg[2], bu[2]; const int j = u.col0 + EPI_COLP(0);
        float ka = -SW_ALPHA * LOG2E, k1 = 1.0f; asm volatile("" : "+v"(ka), "+v"(k1));
        const f32x2 KA = {ka, ka}, K1 = {k1, k1};
#pragma unroll
        for (int n = 0; n < 2; ++n) { bg[n] = *(const f32x4*)(bgu + (size_t)u.e * 2048 + j + 4 * n); bu[n] = *(const f32x4*)(bgu + (size_t)u.e * 2048 + 1024 + j + 4 * n); }
#pragma unroll
        for (int ai = 0; ai < 2; ++ai)
#pragma unroll
            for (int m = 0; m < 4; ++m) { const int row = u.row0 + EPI_ROW(ai, m); f32x4 o[2];
#pragma unroll
                for (int n = 0; n < 2; ++n) { const f32x4 g = acc[ai][0][m][n], up = acc[ai][1][m][n];
#pragma unroll
                    for (int i = 0; i < 4; i += 2) {
                        f32x2 G = (f32x2){g[i], g[i + 1]} + (f32x2){bg[n][i], bg[n][i + 1]}, Uv = (f32x2){up[i], up[i + 1]} + (f32x2){bu[n][i], bu[n][i + 1]};
                        G.x = fminf(G.x, SW_LIMIT); G.y = fminf(G.y, SW_LIMIT);
                        Uv.x = __builtin_amdgcn_fmed3f(Uv.x, -SW_LIMIT, SW_LIMIT); Uv.y = __builtin_amdgcn_fmed3f(Uv.y, -SW_LIMIT, SW_LIMIT);
                        const f32x2 T = G * KA;
                        const f32x2 D = (f32x2){__builtin_amdgcn_exp2f(T.x), __builtin_amdgcn_exp2f(T.y)} + K1;
                        const f32x2 R = {__builtin_amdgcn_rcpf(D.x), __builtin_amdgcn_rcpf(D.y)};
                        const f32x2 O = __builtin_elementwise_fma(Uv, G, G) * R;
                        o[n][i] = O.x; o[n][i + 1] = O.y; } }
                *(u32x4*)(act + (size_t)row * DFF + j) = pk8(o[0], o[1]); }
    } };
struct EpiDN { bf16_t* y; const float* bdn; const float* rowgate;
    static constexpr bool PERM = true;
    template <class U> __device__ __forceinline__ void tile(const U& u, const f32x4 (&acc)[2][2][4][2], int wr, int wc, int fr, int fq, __attribute__((address_space(3))) unsigned char* xb) const {
        const int lane_ = fq * 16 + fr;
        f32x4 b[2][2]; float g[2][4];
#pragma unroll
        for (int bj = 0; bj < 2; ++bj)
#pragma unroll
            for (int n = 0; n < 2; ++n) b[bj][n] = *(const f32x4*)(bdn + (size_t)u.e * DM + u.col0 + EPI_COLP(bj) + 4 * n);
#pragma unroll
        for (int ai = 0; ai < 2; ++ai)
#pragma unroll
            for (int m = 0; m < 4; ++m) g[ai][m] = rowgate[(size_t)u.e * ECAP + u.idx0 + EPI_ROW(ai, m)];
#pragma unroll
        for (int ai = 0; ai < 2; ++ai)
#pragma unroll
            for (int m = 0; m < 4; ++m) { const int row = u.row0 + ai * 128 + wr * 64 + m * 16 + EPI_XROW;
#pragma unroll
                for (int bj = 0; bj < 2; ++bj) *(u32x4*)(y + (size_t)row * DM + u.col0 + bj * 128 + wc * 32 + EPI_XCOL) = epi_xpose(xb, pk8((acc[ai][bj][m][0] + b[bj][0]) * g[ai][m], (acc[ai][bj][m][1] + b[bj][1]) * g[ai][m]), fr, fq, lane_); }
    } };

namespace fg {
#define FG_LAS __attribute__((address_space(3)))
typedef short bf16x8 __attribute__((ext_vector_type(8)));
constexpr int BM = 256, BK = 64, HALF = 128, HTB = HALF * BK * 2, STAGE_BYTES = 8 * HTB, NXCD = 8, WGM = 8;
constexpr int GIDX_OFF = 131072 + 10240;
__host__ __device__ __forceinline__ int lds_byte(int r, int c) { const int st = (r >> 4) * 2 + (c >> 5), rr = r & 15, cc = c & 31, ob = rr * 64 + cc * 2; return st * 1024 + (ob ^ (((ob >> 9) & 1) << 5)); }
__host__ __device__ __forceinline__ void stage_rc(int b, int& R, int& C) { const int st = b / 1024, sb = b % 1024, swz = sb ^ (((sb >> 9) & 1) << 5); R = (st >> 1) * 16 + swz / 64; C = (st & 1) * 32 + (swz % 64) / 2; }

struct FUnit { const bf16_t* B;
               const int* gather; int gcount;
               int arow0;
               int row0, col0, e, idx0; };

struct DenseSched {
    const bf16_t* Bt; int K, nM, nN, nwg, G, c;
    __device__ void init(const bf16_t* Bt_, int M, int N, int K_, int G_, int c_) { Bt = Bt_; K = K_; nM = M / BM; nN = N / BM; nwg = nM * nN; G = G_; c = c_; }
    __device__ __forceinline__ bool next(int i, FUnit& u, int) const {
        const long L = (long)i * G + c; if (L >= nwg) return false;
        int wgid = (int)L; { const int q = nwg / NXCD, r = nwg % NXCD, xcd = wgid % NXCD, off = wgid / NXCD; wgid = (xcd < r ? xcd * (q + 1) : r * (q + 1) + (xcd - r) * q) + off; }
        const int nig = WGM * nN, gid = wgid / nig, fm = gid * WGM, gsz = (nM - fm) < WGM ? (nM - fm) : WGM;
        const int pm = fm + ((wgid % nig) % gsz), pn = (wgid % nig) / gsz;
        u.B = Bt + (size_t)pn * BM * K; u.gather = nullptr; u.gcount = 0; u.arow0 = pm * BM; u.row0 = pm * BM; u.col0 = pn * BM; u.e = 0; u.idx0 = 0; return true;
    }
};
template <int DUAL> struct MoeSched {
    const bf16_t* Wt; const unsigned* cnt; const int* rowtok; const FG_LAS int* pre;
    int G, vcu;
    static constexpr int TN = DUAL ? 8 : 4;
    __device__ __forceinline__ bool next(int i, FUnit& u, int lane) const {
        const int L = i * G + vcu; if (L >= pre[NEXP]) return false;
        const int pv = pre[lane < NEXP ? lane : NEXP];
        const int e = __builtin_popcountll(__ballot(lane < NEXP && L >= pv)) - 1;
        const int loc = L - pre[e], J = (pre[e + 1] - pre[e]) / TN;
        int j, nt; if (DUAL) { const int g = loc / (4 * J), r = loc % (4 * J); j = r >> 2; nt = g * 4 + (r & 3); } else { j = loc >> 2; nt = loc & 3; }
        const int mt = pre[e] / TN + j, c = (int)cnt[e];
        if (DUAL) { u.B = Wt + ((size_t)e * 2048 + nt * 256) * DM; u.gather = rowtok + (size_t)e * ECAP + j * BM; u.gcount = c - j * BM; u.arow0 = 0; u.col0 = nt * 128; }
        else { u.B = Wt + ((size_t)e * 1024 + nt * 256) * DFF; u.gather = nullptr; u.gcount = 0; u.arow0 = mt * BM; u.col0 = nt * 256; }
        u.row0 = mt * BM; u.e = e; u.idx0 = j * BM; return true;
    }
};
__device__ __forceinline__ void moe_prefix(const unsigned* cnt, FG_LAS int* pre, int TN, int tid) {
    if (tid == 0) { int acc = 0; for (int e = 0; e < NEXP; ++e) { pre[e] = acc; acc += (((int)cnt[e] + BM - 1) / BM) * TN; } pre[NEXP] = acc; }
    __syncthreads();
}

template <int DUAL, class Epi, class Sched>
__device__ __forceinline__ void gemm_phase(FG_LAS unsigned char* lds, const bf16_t* A, int K, const Sched& S, const Epi& E, const int tid) {
    const int wid = __builtin_amdgcn_readfirstlane(tid >> 6), lane = tid & 63, wr = wid >> 2, wc = wid & 3, fr = lane & 15, fq = lane >> 4;
    const int nt = K / BK;
    int Rr[2], Cc[2]; unsigned voffB[2];
#pragma unroll
    for (int i = 0; i < 2; ++i) { stage_rc(tid * 16 + i * 8192, Rr[i], Cc[i]);
        const int rho = Rr[i] & 31, Rb = Epi::PERM ? ((Rr[i] & ~31) + 8 * ((rho & 15) >> 2) + 4 * (rho >> 4) + (rho & 3)) : Rr[i];
        voffB[i] = (unsigned)(Rb * K + Cc[i]) * 2u; }
    const size_t kstep = (size_t)(BK * 2);
    const size_t hstep = (size_t)HALF * K * 2;
    const unsigned ldsw = (unsigned)wid * 1024u;
    const int aoff = lds_byte(wr * 64 + fr, fq * 8), boff = lds_byte(wc * 32 + fr, fq * 8);
#define FG_SA(b, h) (((b) * 2 + (h)) * HTB)
#define FG_SB(b, h) ((4 + (b) * 2 + (h)) * HTB)
#define FG_STAGEB(bufoff, gbase) do { _Pragma("unroll") for (int _i = 0; _i < 2; ++_i) \
        __builtin_amdgcn_global_load_lds((const unsigned*)((const char*)(gbase) + voffB[_i]), (FG_LAS unsigned*)(lds + (bufoff) + ldsw + _i * 8192), 16, 0, 0); } while (0)
#define FG_STAGEA(bufoff, o0, o1, kb) do { \
        __builtin_amdgcn_global_load_lds((const unsigned*)((const char*)A + (size_t)(o0) + (kb)), (FG_LAS unsigned*)(lds + (bufoff) + ldsw), 16, 0, 0); \
        __builtin_amdgcn_global_load_lds((const unsigned*)((const char*)A + (size_t)(o1) + (kb)), (FG_LAS unsigned*)(lds + (bufoff) + ldsw + 8192), 16, 0, 0); } while (0)
#define FG_LDA(dst, b, h) do { _Pragma("unroll") for (int m = 0; m < 4; ++m) _Pragma("unroll") for (int k = 0; k < 2; ++k) dst[m][k] = *(const FG_LAS bf16x8*)(lds + FG_SA(b, h) + aoff + m * 2048 + k * 1024); } while (0)
#define FG_LDB(dst, b, h) do { _Pragma("unroll") for (int n = 0; n < 2; ++n) _Pragma("unroll") for (int k = 0; k < 2; ++k) dst[n][k] = *(const FG_LAS bf16x8*)(lds + FG_SB(b, h) + boff + n * 2048 + k * 1024); } while (0)
#define FG_MMA(ai, bj, At, Bt) do { __builtin_amdgcn_s_setprio(1); _Pragma("unroll") for (int m = 0; m < 4; ++m) _Pragma("unroll") for (int n = 0; n < 2; ++n) _Pragma("unroll") for (int k = 0; k < 2; ++k) \
        acc[ai][bj][m][n] = __builtin_amdgcn_mfma_f32_16x16x32_bf16(Bt[n][k], At[m][k], acc[ai][bj][m][n], 0, 0, 0); __builtin_amdgcn_s_setprio(0); } while (0)
#define FG_WAIT_V(n) asm volatile("s_waitcnt vmcnt(" #n ")" ::: "memory")
#define FG_WAIT_L(n) asm volatile("s_waitcnt lgkmcnt(" #n ")" ::: "memory")
#define FG_BAR __builtin_amdgcn_s_barrier()
#define FG_SCHED __builtin_amdgcn_sched_barrier(0)
#define FG_AOFFS(u, dst) do { _Pragma("unroll") for (int h = 0; h < 2; ++h) _Pragma("unroll") for (int i = 0; i < 2; ++i) { const int r_ = h * HALF + Rr[i]; int row_; \
        if ((u).gather) row_ = (r_ < (u).gcount) ? (u).gather[r_] : 0; else row_ = (u).arow0 + r_; dst[h][i] = (unsigned)(row_ * K + Cc[i]) * 2u; } } while (0)
    FUnit cur, nxt; int ui = 0;
    if (!S.next(0, cur, lane)) return;
#ifndef FG_KREP
#define FG_KREP 1
#endif
    f32x4 acc[2][2][4][2];
#pragma unroll
    for (int a = 0; a < 2; ++a)
#pragma unroll
        for (int b = 0; b < 2; ++b)
#pragma unroll
            for (int m = 0; m < 4; ++m)
#pragma unroll
                for (int n = 0; n < 2; ++n) acc[a][b][m][n] = (f32x4){0.f, 0.f, 0.f, 0.f};
    bf16x8 At[4][2], B0[2][2], B1[2][2];
    unsigned ao[2][2], an[2][2];
    FG_AOFFS(cur, ao);
    const char* cB = (const char*)cur.B;
    FG_STAGEB(FG_SB(0, 0), cB); FG_STAGEB(FG_SB(0, 1), cB + hstep); FG_STAGEA(FG_SA(0, 0), ao[0][0], ao[0][1], 0); FG_STAGEA(FG_SA(0, 1), ao[1][0], ao[1][1], 0);
    if (wr == 1) FG_BAR;
    FG_WAIT_V(2); FG_BAR;
    FG_STAGEB(FG_SB(1, 0), cB + kstep); FG_STAGEA(FG_SA(1, 0), ao[0][0], ao[0][1], kstep); FG_STAGEB(FG_SB(1, 1), cB + hstep + kstep);
    FG_WAIT_V(6); FG_BAR;
    for (;;) {
        const bool has_next = S.next((ui + 1) / FG_KREP, nxt, lane);
        const bool nx_gather = has_next && nxt.gather != nullptr;
        if (nx_gather) { if (wid == 0) { int lg_ = lane; asm volatile("" : "+v"(lg_)); __builtin_amdgcn_global_load_lds((const unsigned*)(nxt.gather + lg_ * 4), (FG_LAS unsigned*)(lds + GIDX_OFF), 16, 0, 0); } }
        else if (has_next) { FG_AOFFS(nxt, an); } else {
#pragma unroll
            for (int h = 0; h < 2; ++h)
#pragma unroll
                for (int i = 0; i < 2; ++i) an[h][i] = ao[h][i]; }
        const char* nB = has_next ? (const char*)nxt.B : cB;
        for (int t = 0; t < nt; t += 2) {
            const bool last = (t == nt - 2);
            const size_t k1 = (size_t)(t + 1) * kstep, k2 = last ? 0 : (size_t)(t + 2) * kstep, k3 = k2 + kstep;
            const char* b2 = (last ? nB : cB) + k2; const char* b3 = b2 + kstep;
            if (last && nx_gather) {
#pragma unroll
                for (int h = 0; h < 2; ++h)
#pragma unroll
                    for (int i = 0; i < 2; ++i) { const int r_ = h * HALF + Rr[i]; const int row_ = (r_ < nxt.gcount) ? *(const FG_LAS int*)(lds + GIDX_OFF + r_ * 4) : 0; an[h][i] = (unsigned)(row_ * K + Cc[i]) * 2u; } }
            const unsigned s00 = last ? an[0][0] : ao[0][0], s01 = last ? an[0][1] : ao[0][1], s10 = last ? an[1][0] : ao[1][0], s11 = last ? an[1][1] : ao[1][1];
            FG_LDB(B0, 0, 0); FG_LDB(B1, 0, 1); FG_SCHED; FG_LDA(At, 0, 0); FG_STAGEA(FG_SA(1, 1), ao[1][0], ao[1][1], k1);
            FG_WAIT_V(8); FG_WAIT_L(0); FG_BAR; FG_MMA(0, 0, At, B0); FG_MMA(0, 1, At, B1); FG_BAR; FG_SCHED;
            FG_LDA(At, 0, 1); FG_STAGEB(FG_SB(0, 0), b2); FG_STAGEB(FG_SB(0, 1), b2 + hstep); FG_STAGEA(FG_SA(0, 0), s00, s01, k2);
            FG_WAIT_V(8); FG_WAIT_L(0); FG_BAR; FG_MMA(1, 0, At, B0); FG_MMA(1, 1, At, B1); FG_BAR; FG_SCHED;
            FG_LDB(B0, 1, 0); FG_LDB(B1, 1, 1); FG_SCHED; FG_LDA(At, 1, 0); FG_STAGEA(FG_SA(0, 1), s10, s11, k2);
            FG_WAIT_V(8); FG_WAIT_L(0); FG_BAR; FG_MMA(0, 0, At, B0); FG_MMA(0, 1, At, B1); FG_BAR; FG_SCHED;
            FG_LDA(At, 1, 1); FG_STAGEB(FG_SB(1, 0), b3); FG_STAGEB(FG_SB(1, 1), b3 + hstep); FG_STAGEA(FG_SA(1, 0), s00, s01, k3);
            FG_WAIT_V(8); FG_WAIT_L(0); FG_BAR; FG_MMA(1, 0, At, B0); FG_MMA(1, 1, At, B1); FG_BAR; FG_SCHED;
        }
        if (wr == 0) FG_BAR;
        if (ui % FG_KREP == FG_KREP - 1) { int le_ = lane; asm volatile("" : "+v"(le_));
            E.tile(cur, acc, wr, wc, le_ & 15, le_ >> 4, lds + 131072 + (wid < 4 ? 512 + wid * 1280 : 11264 + (wid - 4) * 1280)); }
        if (!has_next) break;
#pragma unroll
        for (int a = 0; a < 2; ++a)
#pragma unroll
            for (int b = 0; b < 2; ++b)
#pragma unroll
                for (int m = 0; m < 4; ++m)
#pragma unroll
                    for (int n = 0; n < 2; ++n) acc[a][b][m][n] = (f32x4){0.f, 0.f, 0.f, 0.f};
        cur = nxt; cB = nB; ++ui;
#pragma unroll
        for (int h = 0; h < 2; ++h)
#pragma unroll
            for (int i = 0; i < 2; ++i) ao[h][i] = an[h][i];
        if (wr == 1) FG_BAR;
    }
    FG_WAIT_V(0);
    FG_BAR;
#undef FG_SA
#undef FG_SB
#undef FG_STAGEA
#undef FG_STAGEB
#undef FG_LDA
#undef FG_LDB
#undef FG_MMA
#undef FG_WAIT_V
#undef FG_WAIT_L
#undef FG_BAR
#undef FG_SCHED
#undef FG_AOFFS
}
}
constexpr int FAST_LDS = 147456;
constexpr int MISC_OFF = 131072;
__device__ __forceinline__ int vcu_of(int bx, int G) { return (G % 8 == 0) ? (bx % 8) * (G / 8) + bx / 8 : bx; }

namespace at {
#define AT_LAS __attribute__((address_space(3)))
typedef short bf16x8 __attribute__((ext_vector_type(8)));
typedef short s16x4 __attribute__((ext_vector_type(4)));
typedef short v4i16_t __attribute__((ext_vector_type(4)));
typedef float f32x16 __attribute__((ext_vector_type(16)));
typedef __bf16 bf16x2_t __attribute__((ext_vector_type(2)));
__device__ __forceinline__ unsigned cvtpk(float lo, float hi) { f32x2 v = {lo, hi}; bf16x2_t b = __builtin_convertvector(v, bf16x2_t); return __builtin_bit_cast(unsigned, b); }
__device__ __forceinline__ s16x4 vtr(const AT_LAS char* p) { return __builtin_bit_cast(s16x4, __builtin_amdgcn_ds_read_tr16_b64_v4i16((AT_LAS v4i16_t*)p)); }
__device__ __forceinline__ void glds16(const void* g, AT_LAS char* l) { unsigned keep; const unsigned dst = (unsigned)__builtin_amdgcn_readfirstlane((int)(unsigned)(uintptr_t)l);
    asm volatile("s_mov_b32 %0, m0\n\ts_mov_b32 m0, %2\n\ts_nop 0\n\tglobal_load_lds_dwordx4 %1, off\n\ts_mov_b32 m0, %0" : "=&s"(keep) : "v"(g), "s"(dst) : "memory"); }
__device__ __forceinline__ void glds16x4(unsigned voff, const void* sbase, AT_LAS char* l) { unsigned keep; const unsigned dst = (unsigned)__builtin_amdgcn_readfirstlane((int)(unsigned)(uintptr_t)l);
    asm volatile("s_mov_b32 %0, m0\n\ts_mov_b32 m0, %3\n\ts_nop 0\n\tglobal_load_lds_dwordx4 %1, %2\n\tglobal_load_lds_dwordx4 %1, %2 offset:1024\n\tglobal_load_lds_dwordx4 %1, %2 offset:2048\n\tglobal_load_lds_dwordx4 %1, %2 offset:3072\n\ts_mov_b32 m0, %0"
                 : "=&s"(keep) : "v"(voff), "s"(sbase), "s"(dst) : "memory"); }
__device__ __forceinline__ void glds16x2(unsigned voff, const void* sbase, AT_LAS char* l) { unsigned keep; const unsigned dst = (unsigned)__builtin_amdgcn_readfirstlane((int)(unsigned)(uintptr_t)l);
    asm volatile("s_mov_b32 %0, m0\n\ts_mov_b32 m0, %3\n\ts_nop 0\n\tglobal_load_lds_dwordx4 %1, %2\n\tglobal_load_lds_dwordx4 %1, %2 offset:2048\n\ts_mov_b32 m0, %0"
                 : "=&s"(keep) : "v"(voff), "s"(sbase), "s"(dst) : "memory"); }
__device__ __forceinline__ float swapmax(float x) { auto rr = __builtin_amdgcn_permlane32_swap(__float_as_uint(x), __float_as_uint(x), false, false); return fmaxf(__uint_as_float(rr[0]), __uint_as_float(rr[1])); }
__device__ __forceinline__ float swapsum(float x) { auto rr = __builtin_amdgcn_permlane32_swap(__float_as_uint(x), __float_as_uint(x), false, false); return __uint_as_float(rr[0]) + __uint_as_float(rr[1]); }
__device__ __forceinline__ f32x16 qk32(const AT_LAS char* kblk, const bf16x8 (&qr)[4], int r32, int hi) {
    bf16x8 a[4]; const AT_LAS char* rp = kblk + r32 * 128; const int x = r32 & 7;
#pragma unroll
    for (int d0 = 0; d0 < 4; ++d0) a[d0] = *(const AT_LAS bf16x8*)(rp + (((2 * d0 + hi) ^ x) << 4));
    f32x16 p = {};
#pragma unroll
    for (int d0 = 0; d0 < 4; ++d0) p = __builtin_amdgcn_mfma_f32_32x32x16_bf16(a[d0], qr[d0], p, 0, 0, 0);
    return p;
}
__device__ __forceinline__ void qk64(f32x16& p0, f32x16& p1, const AT_LAS char* kt, const bf16x8 (&qr)[4], int r32, int hi) {
    bf16x8 a[4], b[4]; const AT_LAS char* rp = kt + r32 * 128; const int x = r32 & 7;
#pragma unroll
    for (int d0 = 0; d0 < 4; ++d0) { const int so = ((2 * d0 + hi) ^ x) << 4; a[d0] = *(const AT_LAS bf16x8*)(rp + so); b[d0] = *(const AT_LAS bf16x8*)(rp + 4096 + so); }
    p0 = f32x16{}; p1 = f32x16{};
#pragma unroll
    for (int d0 = 0; d0 < 4; ++d0) { p0 = __builtin_amdgcn_mfma_f32_32x32x16_bf16(a[d0], qr[d0], p0, 0, 0, 0); p1 = __builtin_amdgcn_mfma_f32_32x32x16_bf16(b[d0], qr[d0], p1, 0, 0, 0); }
}
__device__ __forceinline__ void pack_p(const f32x16& p, bf16x8& pa0, bf16x8& pa1) {
    u32x4 w0, w1;
    w0.x = cvtpk(p[0], p[1]); w0.y = cvtpk(p[2], p[3]); w0.z = cvtpk(p[4], p[5]); w0.w = cvtpk(p[6], p[7]);
    w1.x = cvtpk(p[8], p[9]); w1.y = cvtpk(p[10], p[11]); w1.z = cvtpk(p[12], p[13]); w1.w = cvtpk(p[14], p[15]);
    pa0 = __builtin_bit_cast(bf16x8, w0); pa1 = __builtin_bit_cast(bf16x8, w1);
}
__device__ __forceinline__ void v_lane_offs(int lane, int hi, int (&a)[2]) {
    const int q = (lane & 15) >> 2, cl = 2 * ((lane >> 4) & 1) + ((lane & 3) >> 1), sub = (lane & 1) * 8;
#pragma unroll
    for (int sec = 0; sec < 2; ++sec) { const int kl = 4 * hi + q + 8 * sec; a[sec] = kl * 128 + ((cl ^ ((kl >> 1) & 7)) << 4) + sub; }
}
template <int NKS> __device__ __forceinline__ void pv_tile(f32x16 (&o)[2], const bf16x8 (&pa)[NKS], const AT_LAS char* vt, int lane, int hi) {
    int a[2]; v_lane_offs(lane, hi, a);
    s16x4 lo[2][NKS], hh[2][NKS];
#pragma unroll
    for (int d0 = 0; d0 < 2; ++d0)
#pragma unroll
        for (int ks = 0; ks < NKS; ++ks) { lo[d0][ks] = vtr(vt + ks * 2048 + (a[0] ^ (d0 * 64))); hh[d0][ks] = vtr(vt + ks * 2048 + (a[1] ^ (d0 * 64))); }
#pragma unroll
    for (int ks = 0; ks < NKS; ++ks)
#pragma unroll
        for (int d0 = 0; d0 < 2; ++d0) { const bf16x8 b = (bf16x8){lo[d0][ks][0], lo[d0][ks][1], lo[d0][ks][2], lo[d0][ks][3], hh[d0][ks][0], hh[d0][ks][1], hh[d0][ks][2], hh[d0][ks][3]};
            o[d0] = __builtin_amdgcn_mfma_f32_32x32x16_bf16(pa[ks], b, o[d0], 0, 0, 0); }
}
__device__ __forceinline__ void pv32(f32x16 (&o)[2], const f32x16& p, const AT_LAS char* vt, int lane, int hi) { bf16x8 pa[2]; pack_p(p, pa[0], pa[1]); pv_tile<2>(o, pa, vt, lane, hi); }
__device__ __forceinline__ void pv64(f32x16 (&o)[2], const f32x16& p0, const f32x16& p1, const AT_LAS char* vt, int lane, int hi) { bf16x8 pa[4]; pack_p(p0, pa[0], pa[1]); pack_p(p1, pa[2], pa[3]); pv_tile<4>(o, pa, vt, lane, hi); }
template <int NBK> __device__ __forceinline__ void softmax_step(f32x16 (&p)[NBK], float& m, float& l, f32x16 (&o)[2], AT_LAS float* wsf, int r32, int hi) {
    float mt = p[0][0];
#pragma unroll
    for (int b = 0; b < NBK; ++b)
#pragma unroll
        for (int r = 0; r < 16; ++r) mt = fmaxf(mt, p[b][r]);
    mt = swapmax(mt);
    const float mn = fmaxf(m, mt);
    if (__any(mt > m + 4.0f)) {
        const float alpha = __builtin_amdgcn_exp2f(m - mn);
        l *= alpha;
        if (hi == 0) wsf[r32] = alpha;
#pragma unroll
        for (int g = 0; g < 4; ++g) { const f32x4 a = *(const AT_LAS f32x4*)(wsf + 8 * g + 4 * hi);
#pragma unroll
            for (int i = 0; i < 4; ++i) { o[0][4 * g + i] *= a[i]; o[1][4 * g + i] *= a[i]; } }
        m = mn;
    }
    float s = 0.f;
#pragma unroll
    for (int b = 0; b < NBK; ++b)
#pragma unroll
        for (int r = 0; r < 16; ++r) { p[b][r] = __builtin_amdgcn_exp2f(p[b][r] - m); s += p[b][r]; }
    l += s;
}
__device__ __forceinline__ void attn_store(const f32x16 (&o)[2], float l, AT_LAS float* wsf, AT_LAS bf16_t* stg, bf16_t* Og, size_t rs, int lane, int r32, int hi) {
    const float lt = swapsum(l);
    if (hi == 0) wsf[32 + r32] = 1.0f / lt;
#pragma unroll
    for (int g = 0; g < 4; ++g) { const f32x4 rl = *(const AT_LAS f32x4*)(wsf + 32 + 8 * g + 4 * hi);
#pragma unroll
        for (int i = 0; i < 4; ++i) { const int orow = 8 * g + 4 * hi + i;
            stg[orow * 64 + r32] = (bf16_t)f2bf(o[0][4 * g + i] * rl[i]); stg[orow * 64 + 32 + r32] = (bf16_t)f2bf(o[1][4 * g + i] * rl[i]); } }
#pragma unroll
    for (int i = 0; i < 4; ++i) { const int row = i * 8 + (lane >> 3), ch = lane & 7; const u32x4 v = *(const AT_LAS u32x4*)(stg + row * 64 + ch * 8); *(u32x4*)(Og + (size_t)row * rs + ch * 8) = v; }
}

constexpr int NRING = 4, LK = 0, LV = NRING * 8192, LW = 2 * NRING * 8192, LO = LW + 2048, LC = LO + 8 * 4096, ATT_LDS = LC + NRING * 1024;
__device__ __forceinline__ void qk64x(f32x16& p0, f32x16& p1, const AT_LAS char* kt, const bf16x8 (&qr)[4], const bf16x8 ax0, const bf16x8 ax1, const bf16x8 qx, int r32, int hi) {
    bf16x8 a[4], b[4]; const AT_LAS char* rp = kt + r32 * 128; const int x = r32 & 7;
#pragma unroll
    for (int d0 = 0; d0 < 4; ++d0) { const int so = ((2 * d0 + hi) ^ x) << 4; a[d0] = *(const AT_LAS bf16x8*)(rp + so); b[d0] = *(const AT_LAS bf16x8*)(rp + 4096 + so); }
    p0 = __builtin_amdgcn_mfma_f32_32x32x16_bf16(ax0, qx, (f32x16){}, 0, 0, 0); p1 = __builtin_amdgcn_mfma_f32_32x32x16_bf16(ax1, qx, (f32x16){}, 0, 0, 0);
#pragma unroll
    for (int d0 = 0; d0 < 4; ++d0) { p0 = __builtin_amdgcn_mfma_f32_32x32x16_bf16(a[d0], qr[d0], p0, 0, 0, 0); p1 = __builtin_amdgcn_mfma_f32_32x32x16_bf16(b[d0], qr[d0], p1, 0, 0, 0); }
}
__device__ __forceinline__ bf16x8 make_qx(float cm, int hi) {
    const unsigned hb = cvtpk(cm, 0.f) & 0xffffu; const float hf = __uint_as_float(hb << 16); const unsigned lb = cvtpk(cm - hf, 0.f) & 0xffffu;
    u32x4 w = (u32x4){hb | (lb << 16), 0x3F803F80u, 0u, 0u}; if (hi) w = (u32x4){0u, 0u, 0u, 0u};
    return __builtin_bit_cast(bf16x8, w);
}
constexpr float AT_THR = 4.0f;
template <int MODE> __device__ __forceinline__ void attn_block_unit(AT_LAS char* lds, const bf16_t* Qp, int ldq, const bf16_t* Kp, const bf16_t* Vp, int ldkv, int NT, int q0, const float* cl, const bf16_t* ckb, bf16_t* Op, int ldo, const int tid) {
    const int lane = tid & 63, r32 = lane & 31, hi = lane >> 5; const int wid = __builtin_amdgcn_readfirstlane(tid >> 6);
    AT_LAS float* wsf = (AT_LAS float*)(lds + LW) + wid * 64; AT_LAS bf16_t* stg = (AT_LAS bf16_t*)(lds + LO) + wid * 2048;
    const int qpos = q0 + wid * 32 + r32;
    const int lrow = wid * 8 + (lane >> 3), lslot = lane & 7;
    const bf16_t* ksrc = Kp + (size_t)lrow * ldkv + ((lslot ^ (lrow & 7)) << 3);
    const bf16_t* vsrc = Vp + (size_t)lrow * ldkv + ((lslot ^ ((lrow >> 1) & 7)) << 3);
    const bool xw = (MODE == 0) && (wid == 0);
#define AT_LOAD(t, bs) do { const int tt_ = NT - 1 - (t); const size_t to_ = (size_t)tt_ * 64 * ldkv; glds16(ksrc + to_, lds + LK + (bs) * 8192 + wid * 1024); glds16(vsrc + to_, lds + LV + (bs) * 8192 + wid * 1024); \
        if (xw) glds16(ckb + ((size_t)(tt_ * 64 + lane) << 3), lds + LC + (bs) * 1024); } while (0)
#define AT_WAITN(n) do { if (xw) { if ((n) >= 2) asm volatile("s_waitcnt vmcnt(6) lgkmcnt(0)" ::: "memory"); else if ((n) == 1) asm volatile("s_waitcnt vmcnt(3) lgkmcnt(0)" ::: "memory"); else asm volatile("s_waitcnt vmcnt(0) lgkmcnt(0)" ::: "memory"); } \
        else { if ((n) >= 2) asm volatile("s_waitcnt vmcnt(4) lgkmcnt(0)" ::: "memory"); else if ((n) == 1) asm volatile("s_waitcnt vmcnt(2) lgkmcnt(0)" ::: "memory"); else asm volatile("s_waitcnt vmcnt(0) lgkmcnt(0)" ::: "memory"); } } while (0)
    AT_LOAD(0, 0); if (NT > 1) AT_LOAD(1, 1); if (NT > 2) AT_LOAD(2, 2);
    bf16x8 qr[4];
#pragma unroll
    for (int d0 = 0; d0 < 4; ++d0) qr[d0] = *(const bf16x8*)(Qp + (size_t)qpos * ldq + d0 * 16 + hi * 8);
    float l = 0.f, cq = 0.f; if (MODE == 0) cq = cl[qpos];
    f32x16 o[2]; o[0] = f32x16{}; o[1] = f32x16{};
#pragma unroll
    for (int d0 = 0; d0 < 4; ++d0) asm volatile("" : "+v"(qr[d0]));
    asm volatile("" : "+v"(cq));
    float cm = cq;
    bf16x8 qx = make_qx(cm, hi);
    unsigned one2 = 0x3F803F80u, zz = 0u; asm volatile("" : "+v"(one2), "+v"(zz));
    const bf16x8 ax_const = __builtin_bit_cast(bf16x8, (u32x4){one2, zz, zz, zz});
    bool first = true;
#define AT_WAIT1(more) do { if (more) { if (xw) asm volatile("s_waitcnt vmcnt(3) lgkmcnt(0)" ::: "memory"); else asm volatile("s_waitcnt vmcnt(2) lgkmcnt(0)" ::: "memory"); } else asm volatile("s_waitcnt vmcnt(0) lgkmcnt(0)" ::: "memory"); } while (0)
#define AT_LIVE(t_) ((MODE == 1) || ((NT - 1 - (t_)) * 64 <= q0 + wid * 32 + 31))
#define AT_QK(t_, P) do { const int bq_ = (t_) & (NRING - 1), kq_ = (NT - 1 - (t_)) * 64; bf16x8 ax0_ = ax_const, ax1_ = ax_const; \
        if (MODE == 0) { ax0_ = *(const AT_LAS bf16x8*)(lds + LC + bq_ * 1024 + r32 * 16); ax1_ = *(const AT_LAS bf16x8*)(lds + LC + bq_ * 1024 + 512 + r32 * 16); } \
        qk64x(P[0], P[1], lds + LK + bq_ * 8192, qr, ax0_, ax1_, qx, r32, hi); \
        if (MODE == 0 && kq_ + 63 > q0 + wid * 32) {                                      \
            _Pragma("unroll") for (int b = 0; b < 2; ++b) _Pragma("unroll") for (int r = 0; r < 16; ++r) { const int key = kq_ + b * 32 + (r & 3) + 8 * (r >> 2) + 4 * hi; if (key > qpos) P[b][r] = -INFINITY; } } } while (0)
#define AT_STEP(t_, PC, PN) do { const int bs = (t_) & (NRING - 1); \
        if ((t_) + 3 < NT) AT_LOAD((t_) + 3, ((t_) + 3) & (NRING - 1));                   \
        const bool ln_ = ((t_) + 1 < NT) && AT_LIVE((t_) + 1); \
        if (ln_) AT_QK((t_) + 1, PN); \
        if (AT_LIVE(t_)) { \
            float mt = PC[0][0]; \
            _Pragma("unroll") for (int b = 0; b < 2; ++b) _Pragma("unroll") for (int r = 0; r < 16; ++r) mt = fmaxf(mt, PC[b][r]); \
            mt = swapmax(mt); \
            if (first || __any(mt > AT_THR)) {                                            \
                const float dl = first ? mt : fmaxf(mt, 0.f); \
                cm -= dl; qx = make_qx(cm, hi); \
                _Pragma("unroll") for (int b = 0; b < 2; ++b) _Pragma("unroll") for (int r = 0; r < 16; ++r) PC[b][r] -= dl; \
                if (ln_) { _Pragma("unroll") for (int b = 0; b < 2; ++b) _Pragma("unroll") for (int r = 0; r < 16; ++r) PN[b][r] -= dl; } \
                if (!first) { const float alpha = __builtin_amdgcn_exp2f(-dl); l *= alpha; \
                    if (hi == 0) wsf[r32] = alpha; \
                    _Pragma("unroll") for (int g = 0; g < 4; ++g) { const f32x4 a = *(const AT_LAS f32x4*)(wsf + 8 * g + 4 * hi); \
                        _Pragma("unroll") for (int i = 0; i < 4; ++i) { o[0][4 * g + i] *= a[i]; o[1][4 * g + i] *= a[i]; } } } \
                first = false; \
            } \
            float sm = 0.f; \
            _Pragma("unroll") for (int b = 0; b < 2; ++b) _Pragma("unroll") for (int r = 0; r < 16; ++r) { PC[b][r] = __builtin_amdgcn_exp2f(PC[b][r]); sm += PC[b][r]; } \
            l += sm; \
            pv64(o, PC[0], PC[1], lds + LV + bs * 8192, lane, hi); \
        } \
        AT_WAIT1((t_) + 3 < NT);                                                           \
        __builtin_amdgcn_s_barrier(); } while (0)
    AT_WAIT1(NT > 2);
    __builtin_amdgcn_s_barrier();
    f32x16 pa[2], pb[2];
    if (AT_LIVE(0)) AT_QK(0, pa);
    for (int t = 0; t < NT; t += 2) { AT_STEP(t, pa, pb); AT_STEP(t + 1, pb, pa); }
#undef AT_STEP
#undef AT_QK
#undef AT_LIVE
#undef AT_WAIT1
#undef AT_LOAD
#undef AT_WAITN
    attn_store(o, l, wsf, stg, Op + (size_t)(q0 + wid * 32) * ldo, (size_t)ldo, lane, r32, hi);
}

constexpr int DW_BYTES = 16384;
__device__ __forceinline__ void attn_dil_wave(AT_LAS char* lds0, AT_LAS char* wl, AT_LAS float* wsf, const bf16_t* QKV, bf16_t* MERGED, int b, int hh, int ib, int rho, int lane) {
    const int r32 = lane & 31, hi = lane >> 5, w8 = rho & 7, h8 = rho >> 3;
    float m = -1e30f, l = 0.f; f32x16 o[2]; o[0] = f32x16{}; o[1] = f32x16{};
    const size_t rowb = (size_t)b * SEQ;
    const unsigned vK = (unsigned)((lane >> 3) * 128 + (((lane & 7) ^ ((lane >> 3) & 7)) << 4)), vV0 = (unsigned)((lane >> 3) * 128 + (((lane & 7) ^ (lane >> 4)) << 4)), vV1 = (unsigned)((lane >> 3) * 128 + (((lane & 7) ^ ((lane >> 4) + 4)) << 4));
#define AT_DLOAD(KB, LO, tt, bs) do { AT_LAS char* bb_ = wl + (bs) * 8192; const char* kt_ = (const char*)(KB) + (size_t)((LO) + 32 * (tt)) * 128; \
            at::glds16x4(vK, kt_, bb_); at::glds16x2(vV0, kt_ + LA_K * 2, bb_ + 4096); at::glds16x2(vV1, kt_ + LA_K * 2 + 1024, bb_ + 4096 + 1024); } while (0)
#define AT_DTILES(QR, KB, LO, NTILE, LQ) do { \
        AT_DLOAD(KB, LO, 0, 0); \
        asm volatile("s_waitcnt vmcnt(0)" ::: "memory"); \
        for (int tt = 0; tt < (NTILE); ++tt) { \
            const int bs = tt & 1; \
            if (tt + 1 < (NTILE)) AT_DLOAD(KB, LO, tt + 1, bs ^ 1); \
            f32x16 p[1]; p[0] = qk32(wl + bs * 8192, QR, r32, hi); \
            const unsigned rel = (unsigned)((LO) + 32 * tt + 4 * hi - ((LQ) - 128));        \
            _Pragma("unroll") for (int r = 0; r < 16; ++r) { if (rel + (unsigned)((r & 3) + 8 * (r >> 2)) > 128u) p[0][r] = -INFINITY; } \
            softmax_step<1>(p, m, l, o, wsf, r32, hi); \
            pv32(o, p[0], wl + bs * 8192 + 4096, lane, hi); \
            asm volatile("s_waitcnt vmcnt(0) lgkmcnt(0)" ::: "memory"); \
        } } while (0)
    {
        const int j = r32 >> 3, r = r32 & 7, i0 = 4 * w8 + j, rho0 = 8 * h8 + r;
        const int lq = 16 * (32 * ib + i0) + rho0;
        const int tmin = 16 * (32 * ib + 4 * w8) + 8 * h8, lo = tmin > 128 ? tmin - 128 : 0, hiL = tmin + 55, ntile = ((hiL - lo) >> 5) + 1;
        const int gb = b * 4 + hh;
        const bf16_t* qrow = QKV + ((size_t)((gb * 16 + rho0) * 128 + 32 * ib + i0) << 6);
        const bf16_t* kbase = QKV + LA_K + ((size_t)(gb * SEQ) << 6);
        bf16x8 qr[4];
#pragma unroll
        for (int d0 = 0; d0 < 4; ++d0) qr[d0] = *(const bf16x8*)(qrow + d0 * 16 + hi * 8);
        AT_DTILES(qr, kbase, lo, ntile, lq);
        __syncthreads();
        AT_LAS float* X = (AT_LAS float*)lds0; AT_LAS float* ML = X + 8 * 32 * 64;
#pragma unroll
        for (int jj = 0; jj < 16; ++jj) { const int qh = (jj & 3) + 8 * (jj >> 2) + 4 * hi, dst = ((qh & 7) * 32 + 4 * w8 + (qh >> 3)) * 64 + r32;
            X[dst] = o[0][jj]; X[dst + 32] = o[1][jj]; }
        *(AT_LAS f32x2*)(ML + ((r * 32 + i0) * 2 + hi) * 2) = (f32x2){m, l};
        __syncthreads();
#pragma unroll
        for (int jj = 0; jj < 16; ++jj) { const int row = (jj & 3) + 8 * (jj >> 2) + 4 * hi, src = (w8 * 32 + row) * 64 + r32;
            o[0][jj] = X[src]; o[1][jj] = X[src + 32]; }
        { const f32x2 ml = *(const AT_LAS f32x2*)(ML + ((w8 * 32 + r32) * 2 + hi) * 2); m = ml.x; l = ml.y; }
        __syncthreads();
    }
    for (int g = 1; g < 3; ++g) {
        const int dsh = 2 * g, d = 1 << dsh, sigma = 16 >> dsh, rd = rho & (d - 1), rhod = rho >> dsh;
        const int lq = sigma * (32 * ib + r32) + rhod;
        const int lq0 = sigma * 32 * ib + rhod, lo = lq0 > 128 ? lq0 - 128 : 0, hiL = lq0 + 31 * sigma, ntile = ((hiL - lo) >> 5) + 1;
        const int gb = (g * 8 + b) * 4 + hh;
        const bf16_t* qbase = QKV + ((size_t)((gb * 16 + rho) * 128 + 32 * ib) << 6);
        const bf16_t* kbase = QKV + LA_K + ((size_t)(gb * SEQ + rd * (SEQ >> dsh)) << 6);
        bf16x8 qr[4];
#pragma unroll
        for (int d0 = 0; d0 < 4; ++d0) qr[d0] = *(const bf16x8*)(qbase + r32 * 64 + d0 * 16 + hi * 8);
        AT_DTILES(qr, kbase, lo, ntile, lq);
    }
#undef AT_DTILES
#undef AT_DLOAD
    attn_store(o, l, wsf, (AT_LAS bf16_t*)wl, MERGED + (rowb + 16 * 32 * ib + rho) * A_OUT + hh * 64, (size_t)16 * A_OUT, lane, r32, hi);
}
}

__device__ __forceinline__ void phase_attn_a(AT_LAS char* lds, const bf16_t* QKV, const bf16_t* MKV, bf16_t* MERGED, int G, int vcu, const int tid) {
    const int lane = tid & 63, wid = __builtin_amdgcn_readfirstlane(tid >> 6);
    for (int un = vcu; un < 256; un += G) {
        const int b = un >> 5, hh = (un >> 3) & 3, ib = (un >> 1) & 3, rho = (un & 1) * 8 + wid;
        at::attn_dil_wave(lds, lds + wid * at::DW_BYTES, (AT_LAS float*)(lds + 131072 + 8192 + wid * 256), QKV, MERGED, b, hh, ib, rho, lane);
    }
    __syncthreads();
    for (int un = vcu; un < 256; un += G) {
        const int b = un >> 5, h = (un >> 3) & 3, qb = un & 7;
        at::attn_block_unit<1>(lds, QKV + LA_QM + ((size_t)((b * 4 + h) * SEQ) << 6), 64, MKV + (size_t)b * MEM_LEN * 512 + h * 64, MKV + (size_t)b * MEM_LEN * 512 + 256 + h * 64, 512, 4, qb * 256, nullptr, nullptr,
                                 MERGED + (size_t)b * SEQ * A_OUT + 256 + h * 64, A_OUT, tid);
    }
}
__device__ __forceinline__ void fox_unit(AT_LAS char* lds, const bf16_t* QKV, const float* CUM, const bf16_t* CKB, bf16_t* MERGED, int bh, int qb, const int tid) {
    const int b = bh / NFOX, h = bh % NFOX;
    const size_t ho = (size_t)(bh * SEQ) << 6;
    at::attn_block_unit<0>(lds, QKV + LB_QF + ho, 64, QKV + ho, QKV + LB_V + ho, 64, 4 * (qb + 1), qb * 256,
                             CUM + (size_t)bh * SEQ, CKB + ((size_t)bh * SEQ << 3), MERGED + (size_t)b * SEQ * B_OUT + h * 64, B_OUT, tid);
}
__device__ __forceinline__ void phase_attn_b(AT_LAS char* lds, const bf16_t* QKV, const float* CUM, const bf16_t* CKB, const bf16_t* MKV, bf16_t* MERGED, int G, int vcu, const int tid) {
    if (G == 256) {
        const int grp = vcu >> 3, s = vcu & 7;
        const unsigned tq[8] = {0x704000u, 0x713010u, 0x722011u, 0x605001u, 0x614102u, 0x623121u, 0x514212u, 0x523222u};
        unsigned code = 0;
#pragma unroll
        for (int i = 0; i < 8; ++i) if (s == i) code = tq[i];
#pragma unroll 1
        for (int k = 0; k < 3; ++k) { const int qb = (code >> (20 - 8 * k)) & 15, pr = (code >> (16 - 8 * k)) & 15; fox_unit(lds, QKV, CUM, CKB, MERGED, grp * 3 + pr, qb, tid); }
    } else {
        for (int un = vcu; un < NB * NFOX * 8; un += G) { const int qb = 7 - un / (NB * NFOX), bh = un % (NB * NFOX); fox_unit(lds, QKV, CUM, CKB, MERGED, bh, qb, tid); }
    }
    for (int un = vcu; un < 256; un += G) {
        const int b = un >> 5, h = (un >> 3) & 3, qb = un & 7;
        at::attn_block_unit<1>(lds, QKV + LB_QM + ((size_t)((b * 4 + h) * SEQ) << 6), 64, MKV + (size_t)b * MEM_LEN * 512 + h * 64, MKV + (size_t)b * MEM_LEN * 512 + 256 + h * 64, 512, 4, qb * 256, nullptr, nullptr,
                                 MERGED + (size_t)b * SEQ * B_OUT + 768 + h * 64, B_OUT, tid);
    }
}
__device__ __forceinline__ void load_wT(float* wT, const float* W, int ldw, int coloff, int nw, int tid) {
    const int nch = nw >> 2;
    for (int i = tid; i < DM * nch; i += 512) { const int d = i & (DM - 1), k = i >> 10; const f32x4 w = *(const f32x4*)(W + (size_t)d * ldw + coloff + 4 * k);
        wT[(4 * k + 0) * DM + d] = w.x; wT[(4 * k + 1) * DM + d] = w.y; wT[(4 * k + 2) * DM + d] = w.z; wT[(4 * k + 3) * DM + d] = w.w; }
}
__device__ __forceinline__ void ln_rows(f32x4 (&v)[4], const float* g, const float* b, int lane) {
    float s = 0.f, q = 0.f;
#pragma unroll
    for (int j = 0; j < 4; ++j) { s += (v[j].x + v[j].y) + (v[j].z + v[j].w); q += (v[j].x * v[j].x + v[j].y * v[j].y) + (v[j].z * v[j].z + v[j].w * v[j].w); }
#pragma unroll
    for (int o = 1; o < 64; o <<= 1) { s += shx(s, o, lane); q += shx(q, o, lane); }
    const float mean = s * (1.f / DM), var = fmaxf(q * (1.f / DM) - mean * mean, 0.f);
    const float rstd = 1.0f / sqrtf(var + LN_EPS);
#pragma unroll
    for (int j = 0; j < 4; ++j) { const f32x4 gg = ((const f32x4*)g)[64 * j + lane], bb = ((const f32x4*)b)[64 * j + lane]; v[j] = (v[j] - mean) * rstd * gg + bb; }
}
__device__ __forceinline__ void ln_rows2(f32x4 (&v0)[4], f32x4 (&v1)[4], const float* g, const float* b, int lane) {
    float s0 = 0.f, q0 = 0.f, s1 = 0.f, q1 = 0.f;
#pragma unroll
    for (int j = 0; j < 4; ++j) { s0 += (v0[j].x + v0[j].y) + (v0[j].z + v0[j].w); q0 += (v0[j].x * v0[j].x + v0[j].y * v0[j].y) + (v0[j].z * v0[j].z + v0[j].w * v0[j].w);
                                  s1 += (v1[j].x + v1[j].y) + (v1[j].z + v1[j].w); q1 += (v1[j].x * v1[j].x + v1[j].y * v1[j].y) + (v1[j].z * v1[j].z + v1[j].w * v1[j].w); }
#pragma unroll
    for (int o = 1; o < 64; o <<= 1) { s0 += shx(s0, o, lane); q0 += shx(q0, o, lane); s1 += shx(s1, o, lane); q1 += shx(q1, o, lane); }
    const float m0 = s0 * (1.f / DM), m1 = s1 * (1.f / DM);
    const float r0 = 1.0f / sqrtf(fmaxf(q0 * (1.f / DM) - m0 * m0, 0.f) + LN_EPS), r1 = 1.0f / sqrtf(fmaxf(q1 * (1.f / DM) - m1 * m1, 0.f) + LN_EPS);
#pragma unroll
    for (int j = 0; j < 4; ++j) { const f32x4 gg = ((const f32x4*)g)[64 * j + lane], bb = ((const f32x4*)b)[64 * j + lane]; v0[j] = (v0[j] - m0) * r0 * gg + bb; v1[j] = (v1[j] - m1) * r1 * gg + bb; }
}
template <int N> __device__ __forceinline__ float reduce_lanes(float (&a)[N], int lane) {
    int n = N, mask = 32;
#pragma unroll
    for (; n > 1; n >>= 1, mask >>= 1) {
        const bool up = (lane & mask) != 0;
#pragma unroll
        for (int i = 0; i < n / 2; ++i) { float lo = a[i], hi = a[i + n / 2]; asm volatile("" : "+v"(lo), "+v"(hi));
            const float mine = up ? hi : lo, oth = up ? lo : hi; a[i] = mine + shx(oth, mask, lane); }
    }
    float r = a[0];
#pragma unroll
    for (; mask >= 1; mask >>= 1) r += shx(r, mask, lane);
    return r;
}
struct RowA { const float* PRE; const float* lng; const float* lnb; const float* wr; const float* br; float* X1; bf16_t* X1B; unsigned* cnt; int* rowtok; float* rowgate; int* tokpos; };
__device__ __forceinline__ void phase_row_a(AT_LAS unsigned char* ldsb, const RowA& P, int G, int bx, const int tid) {
    float* part = (float*)(unsigned char*)ldsb;
    int* s_e = (int*)((unsigned char*)ldsb + MISC_OFF + 512);
    float* s_g = (float*)(s_e + 256);
    int* s_rank = (int*)(s_g + 256);
    int* s_cnt = s_rank + 256;
    int* s_base = s_cnt + 32;
    const int lane = tid & 63, wave = tid >> 6;
    if (tid < 32) s_cnt[tid] = 0;
    __syncthreads();
    for (int blk = bx; blk < NTOK / 64; blk += G) {
        const int t0 = blk * 64;
        f32x4 n0[4], n1[4];
#pragma unroll
        for (int j = 0; j < 4; ++j) { n0[j] = ((const f32x4*)(P.PRE + (size_t)(t0 + wave * 8) * DM))[64 * j + lane]; n1[j] = ((const f32x4*)(P.PRE + (size_t)(t0 + wave * 8 + 1) * DM))[64 * j + lane]; }
#pragma unroll 1
        for (int i = 0; i < 8; i += 2) {
            const int row = t0 + wave * 8 + i;
            f32x4 v0[4], v1[4];
#pragma unroll
            for (int j = 0; j < 4; ++j) { v0[j] = n0[j]; v1[j] = n1[j]; }
            if (i + 2 < 8) {
#pragma unroll
                for (int j = 0; j < 4; ++j) { n0[j] = ((const f32x4*)(P.PRE + (size_t)(row + 2) * DM))[64 * j + lane]; n1[j] = ((const f32x4*)(P.PRE + (size_t)(row + 3) * DM))[64 * j + lane]; } }
            ln_rows2(v0, v1, P.lng, P.lnb, lane);
#pragma unroll
            for (int j = 0; j < 4; ++j) { ((f32x4*)(P.X1 + (size_t)row * DM))[64 * j + lane] = v0[j]; ((f32x4*)(P.X1 + (size_t)(row + 1) * DM))[64 * j + lane] = v1[j];
                ((u32x2*)(P.X1B + (size_t)row * DM))[64 * j + lane] = (u32x2){pk2(v0[j].x, v0[j].y), pk2(v0[j].z, v0[j].w)};
                ((u32x2*)(P.X1B + (size_t)(row + 1) * DM))[64 * j + lane] = (u32x2){pk2(v1[j].x, v1[j].y), pk2(v1[j].z, v1[j].w)}; }
        }
        asm volatile("s_waitcnt vmcnt(0)" ::: "memory");
        __syncthreads();
        {
            const int tb = wave >> 2, ks = wave & 3, ti = lane & 31, kh = lane >> 5;
            const float* xr = P.X1 + (size_t)(t0 + 32 * tb + ti) * DM + ks * 256 + 4 * kh;
            const float* wr = P.wr + (size_t)(ks * 256 + 4 * kh) * NEXP + ti;
            at::f32x16 acc = {};
#pragma unroll 4
            for (int c = 0; c < 32; ++c) {
                const f32x4 xa = __builtin_nontemporal_load((const f32x4*)(xr + 8 * c));
                const float w0 = wr[(8 * c + 0) * NEXP], w1 = wr[(8 * c + 1) * NEXP], w2 = wr[(8 * c + 2) * NEXP], w3 = wr[(8 * c + 3) * NEXP];
                acc = __builtin_amdgcn_mfma_f32_32x32x2f32(xa.x, w0, acc, 0, 0, 0); acc = __builtin_amdgcn_mfma_f32_32x32x2f32(xa.y, w1, acc, 0, 0, 0);
                acc = __builtin_amdgcn_mfma_f32_32x32x2f32(xa.z, w2, acc, 0, 0, 0); acc = __builtin_amdgcn_mfma_f32_32x32x2f32(xa.w, w3, acc, 0, 0, 0);
            }
            float* pw = part + wave * (32 * 33);
#pragma unroll
            for (int r = 0; r < 16; ++r) pw[((r & 3) + 8 * (r >> 2) + 4 * kh) * 33 + ti] = acc[r];
        }
        __syncthreads();
        if (tid < 64) {
            const float* p0 = part + ((tid >> 5) * 4) * (32 * 33) + (tid & 31) * 33;
            float lv[NEXP];
#pragma unroll
            for (int e = 0; e < NEXP; ++e) lv[e] = ((p0[e] + p0[32 * 33 + e]) + (p0[2 * 32 * 33 + e] + p0[3 * 32 * 33 + e])) + P.br[e];
            float tv[4]; int ti4[4];
#pragma unroll
            for (int k = 0; k < 4; ++k) { float bv = lv[0]; int bi = 0;
#pragma unroll
                for (int e = 1; e < NEXP; ++e) if (lv[e] > bv) { bv = lv[e]; bi = e; }
                tv[k] = bv; ti4[k] = bi;
#pragma unroll
                for (int e = 0; e < NEXP; ++e) if (e == bi) lv[e] = -INFINITY; }
            const float e1 = __builtin_amdgcn_exp2f(LOG2E * (tv[1] - tv[0])), e2 = __builtin_amdgcn_exp2f(LOG2E * (tv[2] - tv[0])), e3 = __builtin_amdgcn_exp2f(LOG2E * (tv[3] - tv[0])); const float inv = 1.0f / (1.0f + e1 + e2 + e3);
            const int r4 = tid * 4; s_e[r4 + 0] = ti4[0]; s_e[r4 + 1] = ti4[1]; s_e[r4 + 2] = ti4[2]; s_e[r4 + 3] = ti4[3];
            s_g[r4 + 0] = inv; s_g[r4 + 1] = e1 * inv; s_g[r4 + 2] = e2 * inv; s_g[r4 + 3] = e3 * inv;
        }
        __syncthreads();
        if (tid < 256) s_rank[tid] = atomicAdd(&s_cnt[s_e[tid]], 1);
        __syncthreads();
        if (tid < 32) { const int c = s_cnt[tid]; s_base[tid] = c ? (int)atomicAdd(&P.cnt[tid], (unsigned)c) : 0; }
        __syncthreads();
        if (tid < 256) { const int e = s_e[tid], idx = s_base[e] + s_rank[tid], tok = t0 + (tid >> 2);
            P.rowtok[(size_t)e * ECAP + idx] = tok; P.rowgate[(size_t)e * ECAP + idx] = s_g[tid]; P.tokpos[tok * 4 + (tid & 3)] = e * ECAP + idx; }
        if (tid < 32) s_cnt[tid] = 0;
        __syncthreads();
    }
}
struct RowB { const float* X1; const bf16_t* YROWS; const int* tokpos; const unsigned* cnt; const float* lng; const float* lnb; float* X2; bf16_t* X2B; const float* wsh; const float* bfg; float* FLOG; };
template <int MODE> __device__ __forceinline__ void phase_row_b(AT_LAS unsigned char* ldsb, const RowB& P, int G, int bx, const int tid) {
    float* wT = (float*)(unsigned char*)ldsb;
    int* s_pst = (int*)((unsigned char*)ldsb + MISC_OFF);
    const int lane = tid & 63, wave = tid >> 6;
    if (MODE == 0) load_wT(wT, P.wsh, 1548, 1536, NFOX, tid);
    if (tid == 0) { int acc = 0; for (int e = 0; e < NEXP; ++e) { s_pst[e] = acc * 256; acc += ((int)P.cnt[e] + 255) / 256; } }
    float mybias = 0.f; if (MODE == 0) { const int h = lane >> 2; if (h < NFOX) mybias = P.bfg[h]; }
    __syncthreads();
    for (int row = bx * 8 + wave; row < NTOK; row += G * 8) {
        f32x4 v[4];
        const int4 tp4 = *(const int4*)(P.tokpos + row * 4);
        const int tps[4] = {tp4.x, tp4.y, tp4.z, tp4.w};
        u32x2 w[4][4];
#pragma unroll
        for (int k = 0; k < 4; ++k) { const int tp = tps[k]; const int e = tp >> 14, idx = tp & (ECAP - 1); const size_t yr = (size_t)(s_pst[e] + idx);
#pragma unroll
            for (int j = 0; j < 4; ++j) w[k][j] = ((const u32x2*)(P.YROWS + yr * DM))[64 * j + lane]; }
#pragma unroll
        for (int j = 0; j < 4; ++j) v[j] = ((const f32x4*)(P.X1 + (size_t)row * DM))[64 * j + lane] * DN_ALPHA;
#pragma unroll
        for (int k = 0; k < 4; ++k)
#pragma unroll
            for (int j = 0; j < 4; ++j) { v[j].x += __uint_as_float(w[k][j].x << 16); v[j].y += __uint_as_float(w[k][j].x & 0xffff0000u); v[j].z += __uint_as_float(w[k][j].y << 16); v[j].w += __uint_as_float(w[k][j].y & 0xffff0000u); }
        ln_rows(v, P.lng, P.lnb, lane);
#pragma unroll
        for (int j = 0; j < 4; ++j) ((f32x4*)(P.X2 + (size_t)row * DM))[64 * j + lane] = v[j];
        if (MODE == 0) {
#pragma unroll
            for (int j = 0; j < 4; ++j) ((u32x2*)(P.X2B + (size_t)row * DM))[64 * j + lane] = (u32x2){pk2(v[j].x, v[j].y), pk2(v[j].z, v[j].w)};
            float a[16];
#pragma unroll
            for (int e = 0; e < 16; ++e) { float x = 0.f;
                if (e < NFOX) {
#pragma unroll
                    for (int j = 0; j < 4; ++j) { const f32x4 ww = ((const f32x4*)(wT + e * DM))[64 * j + lane]; x += (v[j].x * ww.x + v[j].y * ww.y) + (v[j].z * ww.z + v[j].w * ww.w); } }
                a[e] = x; }
            const float z = reduce_lanes<16>(a, lane) + mybias;
            if ((lane & 3) == 0 && (lane >> 2) < NFOX) { const float ls = fminf(z, 0.f) - 0.6931471805599453f * __builtin_amdgcn_logf(1.0f + __builtin_amdgcn_exp2f(-LOG2E * fabsf(z)));
                const int b = row >> 11, t = row & (SEQ - 1); P.FLOG[(size_t)(b * NFOX + (lane >> 2)) * SEQ + t] = ls; }
        }
    }
}
__device__ __forceinline__ void phase_cumsum(AT_LAS unsigned char* ldsb, const float* FLOG, float* CUM, bf16_t* CKB, int G, int bx, const int tid) {
    float* wsum = (float*)((unsigned char*)ldsb + MISC_OFF + 4096);
    const int lane = tid & 63, wave = tid >> 6;
    for (int q = bx; q < NB * NFOX; q += G) {
        const size_t base = (size_t)q * SEQ;
        const f32x4 x = ((const f32x4*)(FLOG + base))[tid];
        const float a0 = x.x, a1 = a0 + x.y, a2 = a1 + x.z, a3 = a2 + x.w;
        float incl = a3;
#pragma unroll
        for (int o = 1; o < 64; o <<= 1) { const float y = __int_as_float(__builtin_amdgcn_ds_bpermute(((lane - o) & 63) << 2, __float_as_int(incl))); if (lane >= o) incl += y; }
        if (lane == 63) wsum[wave] = incl;
        __syncthreads();
        float off = 0.f; for (int w = 0; w < wave; ++w) off += wsum[w];
        const float ex = off + incl - a3;
        const f32x4 cv = (f32x4){(ex + a0) * LOG2E, (ex + a1) * LOG2E, (ex + a2) * LOG2E, (ex + a3) * LOG2E};
        ((f32x4*)(CUM + base))[tid] = cv;
#pragma unroll
        for (int i = 0; i < 4; ++i) { const float nc = -cv[i]; const unsigned hb = pk2(nc, 0.f) & 0xffffu; const float hf = __uint_as_float(hb << 16); const unsigned lb = pk2(nc - hf, 0.f) & 0xffffu;
            ((u32x4*)(CKB + (base + (size_t)tid * 4 + i) * 8))[0] = (u32x4){0x3F803F80u, hb | (lb << 16), 0u, 0u}; }
        __syncthreads();
    }
}

#define XB_TMO      128
#define XB_XCNT(j)  (256  + 64 * (j))
#define XB_XSUB(j)  (1280 + 64 * (j))
#define XB_XGEN(j)  (2304 + 64 * (j))
#define XB_TOP      3328
#define XB_TOPGEN   3392
#define XCD_BAR_WORDS 3456
#define XB_SPIN_CAP (1u << 18)
__device__ __forceinline__ unsigned xb_ld(unsigned* p)              { return __hip_atomic_load(p, __ATOMIC_RELAXED, __HIP_MEMORY_SCOPE_AGENT); }
__device__ __forceinline__ unsigned xb_add(unsigned* p, unsigned v) { return __hip_atomic_fetch_add(p, v, __ATOMIC_RELAXED, __HIP_MEMORY_SCOPE_AGENT); }
__device__ __forceinline__ unsigned xb_xcc_id() { return (unsigned)__builtin_amdgcn_s_getreg((3 << 11) | 20) & 0xFu; }
#define XB_SPIN(cond, bar) do { unsigned _sp = 0; while (cond) { __builtin_amdgcn_s_sleep(1); \
    if ((++_sp & 255u) == 0u) { if (xb_ld(&(bar)[XB_TMO])) break; if (_sp > XB_SPIN_CAP) { atomicAdd(&(bar)[XB_TMO], 1u); break; } } } } while (0)
struct XcdBarrier { unsigned* bar; unsigned x; volatile AT_LAS unsigned* st; };
__device__ __forceinline__ XcdBarrier xcd_barrier_post(unsigned* bar, volatile AT_LAS unsigned* st, int tid) {
    XcdBarrier b; b.bar = bar; b.x = xb_xcc_id(); b.st = st;
    if (tid == 0) (void)xb_add(&bar[XB_XCNT(b.x)], 1u);
    return b;
}
__device__ __forceinline__ void xcd_barrier_complete(unsigned* bar, unsigned x, unsigned& nloc, unsigned& nx) {
    const unsigned G = gridDim.x * gridDim.y * gridDim.z;
    unsigned sum, cnt, mine, sp = 0u;
    for (;;) {
        sum = 0u; cnt = 0u; mine = 0u;
#pragma unroll
        for (unsigned j = 0; j < 16; ++j) { const unsigned c = xb_ld(&bar[XB_XCNT(j)]); sum += c; cnt += (c > 0u) ? 1u : 0u; mine = (j == x) ? c : mine; }
        if (sum == G) break;
        __builtin_amdgcn_s_sleep(1);
        if ((++sp & 255u) == 0u) { if (xb_ld(&bar[XB_TMO])) break; if (sp > XB_SPIN_CAP) { atomicAdd(&bar[XB_TMO], 1u); break; } }
    }
    nloc = mine > 0u ? mine : 1u; nx = cnt > 0u ? cnt : 1u;
}
__device__ __forceinline__ void xcd_barrier(const XcdBarrier& b, int tid) {
    asm volatile("s_waitcnt vmcnt(0)" ::: "memory");
    __syncthreads();
    if (tid == 0) {
        unsigned* bar = b.bar; asm volatile("" : "+s"(bar));
        __builtin_amdgcn_s_waitcnt(0);
        unsigned nloc = b.st[0], nx = b.st[1];
        if (nloc == 0u) { xcd_barrier_complete(bar, b.x, nloc, nx); b.st[0] = nloc; b.st[1] = nx; }
        const unsigned old = xb_add(&bar[XB_XSUB(b.x)], 1u);
        const unsigned gen = old / nloc;
        if (old + 1u == (gen + 1u) * nloc) {
            __builtin_amdgcn_fence(__ATOMIC_RELEASE, "agent");
            asm volatile("s_waitcnt vmcnt(0)" ::: "memory");
            const unsigned og = xb_add(&bar[XB_TOP], 1u);
            const unsigned tg = og / nx;
            if (og + 1u == (tg + 1u) * nx) xb_add(&bar[XB_TOPGEN], 1u);
            else XB_SPIN(xb_ld(&bar[XB_TOPGEN]) == tg, bar);
            __builtin_amdgcn_fence(__ATOMIC_ACQUIRE, "agent");
            xb_add(&bar[XB_XGEN(b.x)], 1u);
            asm volatile("s_waitcnt vmcnt(0)" ::: "memory");
        } else {
            XB_SPIN(xb_ld(&bar[XB_XGEN(b.x)]) == gen, bar);
            __builtin_amdgcn_fence(__ATOMIC_ACQUIRE, "agent");
            asm volatile("s_waitcnt vmcnt(0)" ::: "memory");
        }
    }
    __syncthreads();
}

struct TrJob { const float* W; int ldw, K, Np; bf16_t* WT; int nmat; size_t sstride, dstride; };
template <int MAP> __device__ __forceinline__ void tr_job(const TrJob& j, float* scr, int gw, int NGW, int lane) {
    const int nblk = j.Np / 32, per = (j.K / 64) * nblk; const long total = (long)per * j.nmat;
    for (long it = gw; it < total; it += NGW) { const int mat = (int)(it / per), item = (int)(it % per);
        transpose_item<MAP>(j.W + mat * j.sstride, j.ldw, 0, j.K, j.WT + mat * j.dstride, item, nblk, scr, lane); }
}
__device__ __forceinline__ void cvt_rows(const float* src, bf16_t* dst, size_t n8, size_t gt, size_t NGT) {
    for (size_t i = gt; i < n8; i += NGT) { const f32x4 a = ((const f32x4*)src)[2 * i], b = ((const f32x4*)src)[2 * i + 1];
        u32x4 o; o.x = pk2(a.x, a.y); o.y = pk2(a.z, a.w); o.z = pk2(b.x, b.y); o.w = pk2(b.z, b.w); ((u32x4*)dst)[i] = o; }
}

constexpr unsigned STEAL_D0 = 32u * 512u, STEAL_GU = STEAL_D0 + 32u * 1024u, STEAL_TOTAL = STEAL_GU + 32u * 512u;
constexpr int CW_QNEXT = 512, CW_DONE = 576;
__device__ __forceinline__ void steal_convert(AT_LAS unsigned char* lds, unsigned char* lds_gen, const float* w_gu, const float* w_dn, bf16_t* WT_GU, bf16_t* WT_DN, unsigned* qnext, unsigned* done, unsigned limit, int G, int tid) {
    const int lane = tid & 63, wave = __builtin_amdgcn_readfirstlane(tid >> 6);
    float* scr = (float*)lds_gen + wave * 64 * 33;
    volatile AT_LAS unsigned* slot = (volatile AT_LAS unsigned*)(lds + MISC_OFF + 384);
    __syncthreads();
    if (done && tid == 0) __hip_atomic_fetch_add(done, 1u, __ATOMIC_RELAXED, __HIP_MEMORY_SCOPE_AGENT);
    for (;;) {
        if (tid == 0) { unsigned it = 0xFFFFFFFFu;
            const bool alldone = !done || __hip_atomic_load(done, __ATOMIC_RELAXED, __HIP_MEMORY_SCOPE_AGENT) >= (unsigned)G;
            const bool stop = alldone && __hip_atomic_load(qnext, __ATOMIC_RELAXED, __HIP_MEMORY_SCOPE_AGENT) >= limit;
            if (!stop) it = __hip_atomic_fetch_add(qnext, 8u, __ATOMIC_RELAXED, __HIP_MEMORY_SCOPE_AGENT);
            *slot = it; }
        __syncthreads();
        const unsigned it0 = *slot;
        __syncthreads();
        if (it0 >= STEAL_TOTAL) break;
        const unsigned it = it0 + (unsigned)wave;
        if (it < STEAL_D0) { const int mat = (int)(it >> 9), item = (int)(it & 511);
            transpose_item<0>(w_dn + (size_t)mat * DFF * DM, DM, 0, DFF, WT_DN + (size_t)mat * DM * DFF, item, 32, scr, lane); }
        else if (it < STEAL_GU) { const unsigned r = it - STEAL_D0; const int mat = (int)(r >> 10), item = (int)(r & 1023);
            transpose_item<2>(w_gu + (size_t)(32 + mat) * DM * 2048, 2048, 0, DM, WT_GU + (size_t)(32 + mat) * 2048 * DM, item, 64, scr, lane); }
        else if (it < STEAL_TOTAL) { const unsigned r = it - STEAL_GU; const int mat = (int)(r >> 9), item = (int)(r & 511);
            transpose_item<0>(w_dn + (size_t)(32 + mat) * DFF * DM, DM, 0, DFF, WT_DN + (size_t)(32 + mat) * DM * DFF, item, 32, scr, lane); }
    }
}

constexpr int CW_BAR = 4096;
constexpr int NPHASE = 15;
#ifndef PROBE_MASK
#define PROBE_MASK 0
#endif
struct MegaArgs { const float* in[19]; float* out; unsigned char* ws; int ph_lo, ph_hi; };
__device__ __forceinline__ int lane_id_volatile() { int l; asm volatile("v_mbcnt_lo_u32_b32 %0, -1, 0\n\tv_mbcnt_hi_u32_b32 %0, -1, %0" : "=v"(l)); return l; }
#define OPQ_S(x) asm volatile("" : "+s"(x))
#define OPQ_V(x) asm volatile("" : "+v"(x))
__global__ void __launch_bounds__(512, 2) k_mega(MegaArgs a) {
    extern __shared__ __attribute__((aligned(16))) unsigned char lds_raw[];
    AT_LAS unsigned char* lds = (AT_LAS unsigned char*)lds_raw;
    { const int t0 = threadIdx.x; for (int u = t0; u < (FAST_LDS - MISC_OFF) / 4; u += 512) ((AT_LAS unsigned*)(lds + MISC_OFF))[u] = 0u; }
    __syncthreads();
    const int lo = a.ph_lo, hi = a.ph_hi;
    const int wave_s = __builtin_amdgcn_readfirstlane(threadIdx.x >> 6);
    XcdBarrier bar; bar.bar = (unsigned*)(a.ws + WS_CTL) + CW_BAR; bar.x = 0; bar.st = (volatile AT_LAS unsigned*)(lds + MISC_OFF + 256);
    if (hi - lo > 1) bar = xcd_barrier_post((unsigned*)(a.ws + WS_CTL) + CW_BAR, (volatile AT_LAS unsigned*)(lds + MISC_OFF + 256), threadIdx.x);
#define PH_ENTER \
        int tid = wave_s * 64 + lane_id_volatile(); OPQ_V(tid); const __attribute__((address_space(4))) MegaArgs* ap = (const __attribute__((address_space(4))) MegaArgs*)__builtin_amdgcn_kernarg_segment_ptr(); OPQ_S(ap); unsigned char* ws = ap->ws; int G = gridDim.x, bx = blockIdx.x; OPQ_S(G); OPQ_S(bx); const int vcu = vcu_of(bx, G); (void)vcu; \
        const int l = (ph >= 8) ? 1 : 0; unsigned* cnt = (unsigned*)(ws + WS_CTL) + CW_CNT + l * 64; (void)cnt; AT_LAS int* pre = (AT_LAS int*)(lds + MISC_OFF); (void)pre;
#define P_BF(off) ((bf16_t*)(ws + (off)))
#define P_F32(off) ((float*)(ws + (off)))
#define STEAL(k, lim) steal_convert(lds, lds_raw, ap->in[15], ap->in[17], P_BF(WS_WT_GU), P_BF(WS_WT_DN), (unsigned*)(ws + WS_CTL) + CW_QNEXT, (k) < 0 ? nullptr : (unsigned*)(ws + WS_CTL) + CW_DONE + 64 * (k), (lim), G, tid)
#pragma unroll 1
    for (int r0 = 0; r0 < ((lo == 0) ? 1 + (PROBE_MASK & 1) : 0); ++r0) { const int ph = 0; PH_ENTER
            const int lane = tid & 63, wave = __builtin_amdgcn_readfirstlane(tid >> 6);
            float* scr = (float*)lds_raw + wave * 64 * 33;
            const int gw = vcu * 8 + wave, NGW = G * 8;
#define GW_AT(off) ((gw + NGW - ((off) % NGW)) % NGW)
            tr_job<1>(TrJob{ap->in[2], A_IN, DM, A_IN, P_BF(WS_WT_INA), 1, 0, 0}, scr, GW_AT(0), NGW, lane);
            tr_job<0>(TrJob{ap->in[6], 1548, DM, 1536, P_BF(WS_WT_INB), 1, 0, 0}, scr, GW_AT(1280), NGW, lane);
            tr_job<0>(TrJob{ap->in[4], 1024, DM, 1024, P_BF(WS_WT_INB) + (size_t)1536 * DM, 1, 0, 0}, scr, GW_AT(2048), NGW, lane);
            tr_job<0>(TrJob{ap->in[3], DM, A_OUT, DM, P_BF(WS_WT_OUTA), 1, 0, 0}, scr, GW_AT(2560), NGW, lane);
            tr_job<0>(TrJob{ap->in[5], DM, B_OUT, DM, P_BF(WS_WT_OUTB), 1, 0, 0}, scr, GW_AT(2816), NGW, lane);
            tr_job<0>(TrJob{ap->in[8], 512, DM, 512, P_BF(WS_WT_MKV), 2, (size_t)DM * 512, (size_t)512 * DM}, scr, GW_AT(3328), NGW, lane);
            tr_job<2>(TrJob{ap->in[15], 2048, DM, 2048, P_BF(WS_WT_GU), 32, (size_t)DM * 2048, (size_t)2048 * DM}, scr, GW_AT(3840), NGW, lane);
#undef GW_AT
            const size_t gt = (size_t)vcu * 512 + tid, NGT = (size_t)G * 512;
            cvt_rows(ap->in[0], P_BF(WS_XB), (size_t)NTOK * DM / 8, gt, NGT);
            cvt_rows(ap->in[1], P_BF(WS_MEMB), (size_t)NMEMROW * DM / 8, gt, NGT);
        if (hi > 1) xcd_barrier(bar, tid);
    }
#pragma unroll 1
    for (int pp = 2 * (lo < 1 ? 1 : lo); pp < 2 * hi; ++pp) {
        const int ph = pp >> 1;
        if ((pp & 1) && !((PROBE_MASK >> ph) & 1)) continue;
        switch (ph) {
        case 1: { PH_ENTER
            const bf16_t* WT_MKV = P_BF(WS_WT_MKV); const bf16_t* MEMB = P_BF(WS_MEMB); bf16_t* MEMKV = P_BF(WS_MEMKV);
            { fg::DenseSched S; S.init(P_BF(WS_WT_INA), NTOK, A_IN, DM, G, bx); fg::gemm_phase<0>(lds, P_BF(WS_XB), DM, S, EpiInA{P_BF(WS_QKV)}, tid); }
            { fg::DenseSched S; S.init(WT_MKV, NMEMROW, 512, DM, G, (bx + G / 2) % G); fg::gemm_phase<0>(lds, MEMB, DM, S, EpiPlain{MEMKV, 512, 0}, tid); }
            { fg::DenseSched S; S.init(WT_MKV + (size_t)512 * DM, NMEMROW, 512, DM, G, (bx + G / 2 + G - 16) % G); fg::gemm_phase<0>(lds, MEMB, DM, S, EpiPlain{MEMKV + (size_t)NMEMROW * 512, 512, 0}, tid); }
            STEAL(0, 0u);
        } break;
        case 2: { PH_ENTER phase_attn_a((AT_LAS char*)lds, P_BF(WS_QKV), P_BF(WS_MEMKV), P_BF(WS_MERGED), G, vcu, tid); } break;
        case 3: { PH_ENTER fg::DenseSched S; S.init(P_BF(WS_WT_OUTA), NTOK, DM, A_OUT, G, bx); fg::gemm_phase<0>(lds, P_BF(WS_MERGED), A_OUT, S, EpiOut{P_F32(WS_PRE), ap->in[0]}, tid); } break;
        case 4: case 11: { PH_ENTER
            if (l == 1) STEAL(-1, STEAL_GU);
            phase_row_a(lds, RowA{P_F32(WS_PRE), ap->in[9] + l * DM, ap->in[10] + l * DM, ap->in[13] + (size_t)l * DM * NEXP, ap->in[14] + l * NEXP, P_F32(WS_X1), P_BF(WS_X1B), cnt,
                                  (int*)(ws + WS_ROWTOK), P_F32(WS_ROWGATE), (int*)(ws + WS_TOKPOS)}, G, bx, tid); } break;
        case 5: case 12: { PH_ENTER fg::moe_prefix(cnt, pre, 8, tid); fg::MoeSched<1> S{P_BF(WS_WT_GU) + (size_t)l * 32 * 2048 * DM, cnt, (const int*)(ws + WS_ROWTOK), pre, G, vcu};
            fg::gemm_phase<1>(lds, P_BF(WS_X1B), DM, S, EpiGU{P_BF(WS_ACT), ap->in[16] + (size_t)l * 32 * 2048}, tid);
            if (l == 0) STEAL(1, STEAL_D0); else STEAL(4, STEAL_TOTAL); } break;
        case 6: case 13: { PH_ENTER fg::moe_prefix(cnt, pre, 4, tid); fg::MoeSched<0> S{P_BF(WS_WT_DN) + (size_t)l * 32 * DM * DFF, cnt, nullptr, pre, G, vcu};
            fg::gemm_phase<0>(lds, P_BF(WS_ACT), DFF, S, EpiDN{P_BF(WS_YROWS), ap->in[18] + (size_t)l * 32 * DM, P_F32(WS_ROWGATE)}, tid); if (l == 0) STEAL(2, 0u); } break;
        case 7: { PH_ENTER phase_row_b<0>(lds, RowB{P_F32(WS_X1), P_BF(WS_YROWS), (const int*)(ws + WS_TOKPOS), cnt, ap->in[11], ap->in[12], P_F32(WS_X2), P_BF(WS_XB), ap->in[6], ap->in[7], P_F32(WS_FLOG)}, G, bx, tid); } break;
        case 8: { PH_ENTER phase_cumsum(lds, P_F32(WS_FLOG), P_F32(WS_CUM), P_BF(WS_CKB), G, (bx + G / 2) % G, tid);
            fg::DenseSched S; S.init(P_BF(WS_WT_INB), NTOK, B_IN, DM, G, bx); fg::gemm_phase<0>(lds, P_BF(WS_XB), DM, S, EpiInB{P_BF(WS_QKV)}, tid); STEAL(3, 0u); } break;
        case 9: { PH_ENTER phase_attn_b((AT_LAS char*)lds, P_BF(WS_QKV), P_F32(WS_CUM), P_BF(WS_CKB), P_BF(WS_MEMKV) + (size_t)NMEMROW * 512, P_BF(WS_MERGED), G, vcu, tid); } break;
        case 10: { PH_ENTER fg::DenseSched S; S.init(P_BF(WS_WT_OUTB), NTOK, DM, B_OUT, G, bx); fg::gemm_phase<0>(lds, P_BF(WS_MERGED), B_OUT, S, EpiOut{P_F32(WS_PRE), P_F32(WS_X2)}, tid); } break;
        case 14: { PH_ENTER phase_row_b<1>(lds, RowB{P_F32(WS_X1), P_BF(WS_YROWS), (const int*)(ws + WS_TOKPOS), cnt, ap->in[11] + DM, ap->in[12] + DM, ap->out, nullptr, nullptr, nullptr, nullptr}, G, bx, tid); } break;
        default: break;
        }
#undef PH_ENTER
        if (pp + 1 < 2 * hi) { int tb = wave_s * 64 + lane_id_volatile(); OPQ_V(tb); xcd_barrier(bar, tb);
#if defined(PROBE_BAR)
            xcd_barrier(bar, tb);
#endif
        }
    }
}

#ifndef N_LAUNCHES
#define N_LAUNCHES 1
#endif
extern "C" void kernel_launch(void* const* d_in, const int* in_sizes, int n_in, void* d_out, int out_size, void* d_ws, size_t ws_size, hipStream_t stream) {
    static int grid = 0;
    if (grid == 0) {
        if (n_in != 19 || out_size != NTOK * DM || ws_size < WS_END) { fprintf(stderr, "kernel_launch: unexpected shapes (n_in %d out %d ws %zu)\n", n_in, out_size, ws_size); grid = -1; return; }
        int dev = 0, cus = 0;
        if (hipGetDevice(&dev) != hipSuccess || hipDeviceGetAttribute(&cus, hipDeviceAttributeMultiprocessorCount, dev) != hipSuccess || cus <= 0) { fprintf(stderr, "kernel_launch: device query failed\n"); grid = -1; return; }
        if (hipFuncSetAttribute((const void*)k_mega, hipFuncAttributeMaxDynamicSharedMemorySize, FAST_LDS) != hipSuccess) { fprintf(stderr, "kernel_launch: hipFuncSetAttribute failed\n"); grid = -1; return; }
        grid = cus;
    }
    if (grid < 0) return;
    (void)hipMemsetAsync((char*)d_ws + WS_CTL, 0, 1 * MiB, stream);
    MegaArgs a{};
    for (int i = 0; i < 19; ++i) a.in[i] = (const float*)d_in[i];
    a.out = (float*)d_out; a.ws = (unsigned char*)d_ws;
    if (N_LAUNCHES == 1) { a.ph_lo = 0; a.ph_hi = NPHASE; hipLaunchKernelGGL(k_mega, dim3(grid), dim3(512), FAST_LDS, stream, a); }
    else for (int p = 0; p < NPHASE; ++p) { a.ph_lo = p; a.ph_hi = p + 1; hipLaunchKernelGGL(k_mega, dim3(grid), dim3(512), FAST_LDS, stream, a); }
}
```
